# Optimizing an MI355X kernel written in HIP

```python
import math
import jax, jax.numpy as jnp
from jax import lax
import numpy as np

D_MODEL = 2048
BATCH = 2
SEQ = 4096
DEPTH = 1

N_META = 16
BLOCK = 128
PAD = (-N_META) % BLOCK
EPS = 1e-6
NEG_INF = -1e30

H_DA = 4
DK_DA = 128
DV_DA = 2 * DK_DA
H_M = 4
DK_M = 128
DV_M = 256
CONV_W = 5
N_BUCKETS = 32
MAX_DISTANCE = 128
N_EXPERTS = 32
TOP_K = 4
D_FF = 2048
SWIGLU_ALPHA = 1.702
SWIGLU_LIMIT = 7.0
MOE_BLOCK = 128

DA_Q = H_DA * 2 * DK_DA
DA_K = H_DA * 2 * DK_DA
DA_V = H_DA * DV_DA
M_Q = H_M * DK_M
M_K = H_M * DK_M
M_V = H_M * DV_M
M_O = H_M * DV_M
M_G = 4 * H_M
IN_SIZES = (DA_Q, DA_K, DA_V, M_Q, M_K, M_V, M_O, M_G)
IN_COLS = sum(IN_SIZES)
SPLIT_POINTS = tuple(int(s) for s in np.cumsum(IN_SIZES)[:-1])
W_DA = H_DA * DV_DA
W_M = H_M * DV_M

kernel_name = 'hybrid_diffattn_mlstm_moe_block'


def rmsnorm(x, gain):
    xf = x.astype(jnp.float32)
    y = xf * lax.rsqrt(jnp.mean(xf * xf, axis=-1, keepdims=True) + EPS)
    return (y * gain.astype(jnp.float32)).astype(x.dtype)


def front_pad(t, axis, value=0.0):
    widths = [(0, 0)] * t.ndim
    widths[axis] = (PAD, 0)
    return jnp.pad(t, widths, constant_values=value)


def t5_bucket(rel):
    nb = N_BUCKETS // 2
    max_exact = nb // 2
    base = jnp.where(rel > 0, nb, 0)
    n = jnp.abs(rel)
    nf = jnp.maximum(n, 1).astype(jnp.float32)
    large = max_exact + (jnp.log(nf / max_exact) / math.log(MAX_DISTANCE / max_exact)
                         * (nb - max_exact)).astype(jnp.int32)
    large = jnp.minimum(large, nb - 1)
    return base + jnp.where(n < max_exact, n, large)


def lambda_init(layer):
    return 0.8 - 0.6 * math.exp(-0.3 * layer)


def diff_attention(q, k, v, rel_bias, lam_params, subln_gain, lam_init):
    B, Lp = q.shape[:2]
    q = q.reshape(B, Lp, H_DA, 2, DK_DA).transpose(3, 0, 2, 1, 4)
    k = k.reshape(B, Lp, H_DA, 2, DK_DA).transpose(3, 0, 2, 1, 4)
    v = v.reshape(B, Lp, H_DA, DV_DA).transpose(0, 2, 1, 3)
    lp = lam_params.astype(jnp.float32)
    lam = jnp.exp(jnp.sum(lp[0] * lp[1])) - jnp.exp(jnp.sum(lp[2] * lp[3])) + lam_init
    pos = jnp.arange(Lp) - PAD
    key_valid = pos >= 0
    scale = DK_DA ** -0.5

    def block(j):
        q_blk = lax.dynamic_slice_in_dim(q, j * BLOCK, BLOCK, axis=3)
        q_pos = lax.dynamic_slice_in_dim(pos, j * BLOCK, BLOCK)
        bias = rel_bias[t5_bucket(pos[None, :] - q_pos[:, None])].astype(jnp.float32)
        bias = jnp.where(key_valid[None, :, None], bias, NEG_INF).transpose(2, 0, 1)
        s = jnp.einsum('mbhqd,mbhkd->mbhqk', q_blk, k,
                       preferred_element_type=jnp.float32) * scale + bias
        p = jax.nn.softmax(s, axis=-1)
        a = p[0] - lam * p[1]
        return jnp.einsum('bhqk,bhkd->bhqd', a.astype(v.dtype), v,
                          preferred_element_type=jnp.float32)

    o = lax.map(block, jnp.arange(Lp // BLOCK))
    o = o.transpose(1, 2, 0, 3, 4).reshape(B, H_DA, Lp, DV_DA)
    o = rmsnorm(o, subln_gain) * (1.0 - lam_init)
    o = o[:, :, PAD:].transpose(0, 2, 1, 3).reshape(B, Lp - PAD, W_DA)
    return o.astype(q.dtype)


def mlstm_chunkwise(q, k, v, log_i, log_f):
    B, H, Lp, DK = q.shape
    DV = v.shape[-1]
    nc = Lp // BLOCK
    chunks = lambda t: jnp.moveaxis(t.reshape(B, H, nc, BLOCK, *t.shape[3:]), 2, 0)
    qc, kc, vc = chunks(q * DK ** -0.5), chunks(k), chunks(v)
    lic, lfc = chunks(log_i), chunks(log_f)
    causal_in_chunk = jnp.tril(jnp.ones((BLOCK, BLOCK), dtype=bool))

    def step(carry, inp):
        C, n, m = carry
        qb, kb, vb, li, lf = inp
        b = jnp.cumsum(lf, axis=-1)
        dmat = jnp.where(causal_in_chunk, b[..., :, None] - b[..., None, :] + li[..., None, :], -jnp.inf)
        inter = b + m[..., None]
        m_t = jnp.maximum(inter, jnp.max(dmat, axis=-1))
        w_inter = jnp.exp(inter - m_t)
        s = jnp.einsum('bhtd,bhsd->bhts', qb, kb) * jnp.exp(dmat - m_t[..., None])
        num = w_inter[..., None] * jnp.einsum('bhtd,bhde->bhte', qb, C) + jnp.einsum('bhts,bhse->bhte', s, vb)
        den = w_inter * jnp.einsum('bhtd,bhd->bht', qb, n) + jnp.sum(s, axis=-1)
        h = num / jnp.maximum(jnp.abs(den), jnp.exp(-m_t))[..., None]
        b_end = b[..., -1]
        ldec = b_end[..., None] - b + li
        m_new = jnp.maximum(b_end + m, jnp.max(ldec, axis=-1))
        w_c = jnp.exp(b_end + m - m_new)
        w_s = jnp.exp(ldec - m_new[..., None])
        C = w_c[..., None, None] * C + jnp.einsum('bhs,bhsd,bhse->bhde', w_s, kb, vb)
        n = w_c[..., None] * n + jnp.einsum('bhs,bhsd->bhd', w_s, kb)
        return (C, n, m_new), h

    init = (jnp.zeros((B, H, DK, DV), jnp.float32), jnp.zeros((B, H, DK), jnp.float32),
            jnp.zeros((B, H), jnp.float32))
    _, hs = lax.scan(step, init, (qc, kc, vc, lic, lfc))
    return jnp.moveaxis(hs, 0, 2).reshape(B, H, Lp, DV)


def centred_conv(u, w):
    half = CONV_W // 2
    L = u.shape[1]
    up = jnp.pad(u, ((0, 0), (half, half), (0, 0)))
    return sum(w[j] * up[:, j:j + L] for j in range(CONV_W))


def mlstm_branch(q, k, v, o, gates, gate_bias):
    B, L = q.shape[:2]
    g = gates.reshape(B, L, 4, H_M).astype(jnp.float32) + gate_bias.astype(jnp.float32)
    g = g.transpose(2, 0, 3, 1)
    heads = lambda t, d: front_pad(t.reshape(B, L, H_M, d).transpose(0, 2, 1, 3).astype(jnp.float32), axis=2)
    qh, kh, vh = heads(q, DK_M), heads(k, DK_M), heads(v, DV_M)
    li_f = front_pad(g[0], axis=2, value=-jnp.inf)
    lf_f = front_pad(jax.nn.log_sigmoid(g[1]), axis=2, value=0.0)
    li_b = front_pad(g[2], axis=2, value=-jnp.inf)
    lf_b = front_pad(jax.nn.log_sigmoid(g[3]), axis=2, value=0.0)
    flip = lambda t: jnp.flip(t, axis=2)
    h_fwd = mlstm_chunkwise(qh, kh, vh, li_f, lf_f)
    h_bwd = flip(mlstm_chunkwise(flip(qh), flip(kh), flip(vh), flip(li_b), flip(lf_b)))
    h = (h_fwd + h_bwd)[:, :, PAD:].transpose(0, 2, 1, 3).reshape(B, L, W_M)
    return (jax.nn.sigmoid(o.astype(jnp.float32)) * h).astype(q.dtype)


def moe_ffn(t, w_router, b_router, w1, b1, w2, b2):
    N, D = t.shape
    A = N * TOP_K
    n_blocks = -(-A // MOE_BLOCK) + N_EXPERTS
    logits = jnp.dot(t, w_router, preferred_element_type=jnp.float32) + b_router.astype(jnp.float32)
    top_logit, top_e = lax.top_k(logits, TOP_K)
    weight = jax.nn.softmax(top_logit, axis=-1)
    flat_e = top_e.reshape(A)
    order = jnp.argsort(flat_e)
    sorted_e = flat_e[order]
    counts = jnp.bincount(flat_e, length=N_EXPERTS)
    padded = (counts + MOE_BLOCK - 1) // MOE_BLOCK * MOE_BLOCK
    start = jnp.cumsum(counts) - counts
    pstart = jnp.cumsum(padded) - padded
    dest_sorted = pstart[sorted_e] + jnp.arange(A) - start[sorted_e]
    dest = jnp.zeros((A,), jnp.int32).at[order].set(dest_sorted.astype(jnp.int32))
    slot_tok = jnp.full((n_blocks * MOE_BLOCK,), N, jnp.int32).at[dest].set(jnp.arange(A, dtype=jnp.int32) // TOP_K)
    block_e = jnp.minimum(jnp.searchsorted(jnp.cumsum(padded), jnp.arange(n_blocks) * MOE_BLOCK, side='right'),
                          N_EXPERTS - 1)
    t_pad = jnp.concatenate([t, jnp.zeros((1, D), t.dtype)], axis=0)
    xb = t_pad[slot_tok].reshape(n_blocks, MOE_BLOCK, D)

    def expert_block(args):
        xblk, e = args
        hu = xblk @ w1[e] + b1[e]
        glu, lin = jnp.split(hu, 2, axis=-1)
        glu = jnp.minimum(glu, SWIGLU_LIMIT)
        lin = jnp.clip(lin, -SWIGLU_LIMIT, SWIGLU_LIMIT)
        act = glu * jax.nn.sigmoid(SWIGLU_ALPHA * glu) * (lin + 1.0)
        return act @ w2[e] + b2[e]

    yb = lax.map(expert_block, (xb, block_e)).reshape(n_blocks * MOE_BLOCK, D)
    y = yb[dest].reshape(N, TOP_K, D)
    return jnp.einsum('nk,nkd->nd', weight.astype(y.dtype), y)


def setup_inputs(seed: int = 0) -> dict:
    key = jax.random.key(seed)
    ks = jax.random.split(key, 24)
    nrm = lambda k, shape, s: jax.random.normal(k, shape, jnp.float32) * s
    fb = jnp.array([0.0, 1.0, 0.0, 1.0], jnp.float32)[:, None] * jnp.linspace(3.0, 6.0, H_M)[None, :]
    return {
        'x': nrm(ks[0], (BATCH, SEQ, D_MODEL), 1.0),
        'meta_tokens': nrm(ks[1], (N_META, D_MODEL), 1.0),
        'rel_bias': nrm(ks[2], (N_BUCKETS, H_DA), 0.5),
        'norm_mix': 1.0 + nrm(ks[3], (DEPTH, D_MODEL), 0.05),
        'w_in': nrm(ks[4], (DEPTH, D_MODEL, IN_COLS), D_MODEL ** -0.5),
        'conv_w': nrm(ks[5], (DEPTH, CONV_W, M_Q + M_K), CONV_W ** -0.5),
        'gate_bias_m': fb[None] + nrm(ks[6], (DEPTH, 4, H_M), 0.1),
        'lambda_params': nrm(ks[7], (DEPTH, 4, DK_DA), 0.1),
        'subln_da': 1.0 + nrm(ks[8], (DEPTH, DV_DA), 0.05),
        'w_branch_da': nrm(ks[9], (DEPTH, W_DA, D_MODEL), W_DA ** -0.5),
        'w_branch_m': nrm(ks[10], (DEPTH, W_M, D_MODEL), W_M ** -0.5),
        'w_gate': nrm(ks[11], (DEPTH, D_MODEL, 2 * D_MODEL), D_MODEL ** -0.5),
        'b_gate': nrm(ks[12], (DEPTH, 2 * D_MODEL), 0.1),
        'w_out': nrm(ks[13], (DEPTH, D_MODEL, D_MODEL), D_MODEL ** -0.5),
        'norm_ffn': 1.0 + nrm(ks[14], (DEPTH, D_MODEL), 0.05),
        'w_router': nrm(ks[15], (DEPTH, D_MODEL, N_EXPERTS), D_MODEL ** -0.5),
        'b_router': nrm(ks[16], (DEPTH, N_EXPERTS), 0.01),
        'w1': nrm(ks[17], (DEPTH, N_EXPERTS, D_MODEL, 2 * D_FF), D_MODEL ** -0.5),
        'b1': nrm(ks[18], (DEPTH, N_EXPERTS, 2 * D_FF), 0.01),
        'w2': nrm(ks[19], (DEPTH, N_EXPERTS, D_FF, D_MODEL), D_FF ** -0.5),
        'b2': nrm(ks[20], (DEPTH, N_EXPERTS, D_MODEL), 0.01),
        'norm_final': 1.0 + nrm(ks[21], (D_MODEL,), 0.05),
    }


def reference(x, meta_tokens, rel_bias, norm_mix, w_in, conv_w, gate_bias_m, lambda_params, subln_da,
              w_branch_da, w_branch_m, w_gate, b_gate, w_out, norm_ffn, w_router, b_router,
              w1, b1, w2, b2, norm_final):
    B = x.shape[0]
    meta = jnp.broadcast_to(meta_tokens[None].astype(x.dtype), (B, N_META, D_MODEL))
    h = jnp.concatenate([meta, x], axis=1)
    L = h.shape[1]
    for layer in range(DEPTH):
        xn = rmsnorm(h, norm_mix[layer])
        proj = xn @ w_in[layer]
        da_q, da_k, da_v, m_q, m_k, m_v, m_o, m_g = jnp.split(proj, SPLIT_POINTS, axis=-1)
        y_da = diff_attention(front_pad(da_q, 1), front_pad(da_k, 1), front_pad(da_v, 1), rel_bias,
                              lambda_params[layer], subln_da[layer], lambda_init(layer))
        m_qk = jax.nn.silu(centred_conv(jnp.concatenate([m_q, m_k], axis=-1), conv_w[layer]))
        m_q, m_k = jnp.split(m_qk, 2, axis=-1)
        y_m = mlstm_branch(m_q, m_k, m_v, m_o, m_g, gate_bias_m[layer])
        g = jax.nn.sigmoid((xn @ w_gate[layer] + b_gate[layer]).astype(jnp.float32)).reshape(B, L, 2, D_MODEL)
        mixed = g[:, :, 0] * (y_da @ w_branch_da[layer]) + g[:, :, 1] * (y_m @ w_branch_m[layer])
        h = h + mixed.astype(h.dtype) @ w_out[layer]
        hn = rmsnorm(h, norm_ffn[layer]).reshape(B * L, D_MODEL)
        ff = moe_ffn(hn, w_router[layer], b_router[layer], w1[layer], b1[layer], w2[layer], b2[layer])
        h = h + ff.reshape(B, L, D_MODEL).astype(h.dtype)
    h = rmsnorm(h, norm_final)
    return h[:, N_META:]
```

```cpp
#include <hip/hip_runtime.h>
#include <cstdio>
#include <cstdint>

constexpr int NB = 2, SEQ = 4096, D = 2048, NMETA = 16, PADF = 112, L = 4112, LP = 4224, R = NB * LP;
constexpr int INC = 6160;
constexpr int C_DAQ = 0, C_DAK = 1024, C_DAV = 2048, C_MQ = 3072, C_MK = 3584, C_MV = 4096, C_MO = 5120, C_MG = 6144;
constexpr int NE = 32, TOPK = 4, DFF = 2048;
constexpr float EPS = 1e-6f;
constexpr int MAXSLOT = R * TOPK;

__device__ __forceinline__ float wave_sum(float v) { for (int o = 32; o >= 1; o >>= 1) v += __shfl_xor(v, o); return v; }
__device__ __forceinline__ float wave_max(float v) { for (int o = 32; o >= 1; o >>= 1) v = fmaxf(v, __shfl_xor(v, o)); return v; }
__device__ __forceinline__ float block_sum256(float v, float* red) {
    v = wave_sum(v); __syncthreads(); if ((threadIdx.x & 63) == 0) red[threadIdx.x >> 6] = v; __syncthreads();
    return red[0] + red[1] + red[2] + red[3];
}
__device__ __forceinline__ float block_max256(float v, float* red) {
    v = wave_max(v); __syncthreads(); if ((threadIdx.x & 63) == 0) red[threadIdx.x >> 6] = v; __syncthreads();
    return fmaxf(fmaxf(red[0], red[1]), fmaxf(red[2], red[3]));
}
__device__ __forceinline__ float sigmoidf_(float x) { return 1.0f / (1.0f + __expf(-x)); }
__device__ __forceinline__ float logsigmoidf_(float x) { return fminf(x, 0.f) - log1pf(__expf(-fabsf(x))); }
__device__ __forceinline__ int t5_bucket(int rel) {
    const int n = rel < 0 ? -rel : rel; int v;
    if (n < 8) v = n; else { const int t = n * n; int k = 0; while (k < 7 && t >= (128 << k)) ++k; v = 8 + k; if (v > 15) v = 15; }
    return v + (rel > 0 ? 16 : 0);
}

#define LAS __attribute__((address_space(3)))
typedef unsigned short bf16_t;
typedef short bf16x8 __attribute__((ext_vector_type(8)));
typedef float f32x4 __attribute__((ext_vector_type(4)));
typedef float f32x2 __attribute__((ext_vector_type(2)));
typedef unsigned u32x4 __attribute__((ext_vector_type(4)));
typedef unsigned u32x2 __attribute__((ext_vector_type(2)));
constexpr int NPROJ = 10240;
constexpr int LDS_BYTES = 163840;
constexpr int NWG = 256;
#ifndef P1_WORKERS_
#define P1_WORKERS_ 144
#endif
constexpr int P1_WORKERS = P1_WORKERS_;
constexpr int NTOK = NB * SEQ;
constexpr int ECAP = 8192;
constexpr int MOE_ROWS = NTOK * TOPK + NE * 256;
constexpr int TAB_OFF = 131072;

__device__ __forceinline__ int otid() { int t = threadIdx.x; asm volatile("" : "+v"(t)); return t; }
__device__ __forceinline__ unsigned cvt_pk_bf16(float lo, float hi) { unsigned r; asm volatile("v_cvt_pk_bf16_f32 %0, %1, %2" : "=v"(r) : "v"(lo), "v"(hi)); return r; }
__device__ __forceinline__ unsigned pk4_fp8(float a, float b, float c, float d) { int w = __builtin_amdgcn_cvt_pk_fp8_f32(a, b, 0, false); w = __builtin_amdgcn_cvt_pk_fp8_f32(c, d, w, true); return (unsigned)w; }
typedef int i32x8 __attribute__((ext_vector_type(8)));
constexpr float W8_SCALE = 64.0f;
__device__ __forceinline__ float bf2f(bf16_t b) { return __uint_as_float(((unsigned)b) << 16); }
__device__ __forceinline__ float bflo(unsigned w) { return __uint_as_float(w << 16); }
__device__ __forceinline__ float bfhi(unsigned w) { return __uint_as_float(w & 0xffff0000u); }

constexpr size_t al256(size_t x) { return (x + 255) / 256 * 256; }
constexpr size_t WS_CTL = 0;
constexpr size_t WS_WINT = WS_CTL + 65536;
constexpr size_t WS_WBRT = WS_WINT + al256((size_t)NPROJ * 2048 * 2);
constexpr size_t WS_WOUTT = WS_WBRT + al256((size_t)4096 * 1024 * 2);
constexpr size_t WS_W1T = WS_WOUTT + al256((size_t)2048 * 2048 * 2);
constexpr size_t WS_W2T = WS_W1T + al256((size_t)NE * 4096 * 2048 * 2);
constexpr size_t WS_XN = WS_W2T + al256((size_t)NE * 2048 * 2048 * 2);
constexpr size_t WS_GATES = WS_XN + al256((size_t)R * D * 2);
constexpr size_t WS_BIASP = WS_GATES + al256((size_t)R * 16 * 4);
constexpr size_t WS_P = WS_BIASP + al256((size_t)NPROJ * 4);
constexpr size_t WS_YDM = WS_P + al256((size_t)R * NPROJ * 2);
constexpr size_t WS_OS = WS_YDM + al256((size_t)2 * NTOK * 1024 * 2);
constexpr size_t WS_TMIX = WS_OS + al256((size_t)NTOK * 1024 * 4);
constexpr size_t WS_MIX = WS_TMIX + al256((size_t)NTOK * D * 4);
constexpr size_t WS_H1 = WS_MIX + al256((size_t)NTOK * D * 2);
constexpr size_t WS_HN = WS_H1 + al256((size_t)NTOK * D * 4);
constexpr size_t WS_TOPW = WS_HN + al256((size_t)NTOK * D * 2);
constexpr size_t WS_DEST = WS_TOPW + al256((size_t)NTOK * 4 * 4);
constexpr size_t WS_LIST = WS_DEST + al256((size_t)NTOK * 4 * 4);
constexpr size_t WS_ACT = WS_LIST + al256((size_t)NE * ECAP * 4);
constexpr size_t WS_Y = WS_ACT + al256((size_t)MOE_ROWS * DFF * 2);
constexpr size_t WS_QC = WS_Y + al256((size_t)MOE_ROWS * D * 2);
constexpr size_t WS_KC = WS_QC + al256((size_t)R * 512 * 2);
constexpr size_t WS_GB = WS_KC + al256((size_t)R * 512 * 2);
constexpr size_t WS_GA = WS_GB + al256((size_t)16 * LP * 4);
constexpr size_t WS_GPM = WS_GA + al256((size_t)16 * LP * 4);
constexpr size_t WS_CS = WS_GPM + al256((size_t)16 * LP * 4);
constexpr size_t WS_DC = WS_CS + al256((size_t)16 * 33 * 2 * 4);
constexpr size_t WS_DN = WS_DC + al256((size_t)16 * 33 * 128 * 256 * 4);
constexpr size_t WS_CST = WS_DN + al256((size_t)16 * 33 * 128 * 4);
constexpr size_t WS_NST = WS_CST + al256((size_t)16 * 33 * 128 * 256 * 2);
constexpr size_t WS_MST = WS_NST + al256((size_t)16 * 33 * 128 * 4);
constexpr size_t WS_HS = WS_MST + al256((size_t)16 * 33 * 4);
constexpr size_t WS_MTAB = WS_HS + al256((size_t)NTOK * 1024 * 4);
constexpr size_t WS_XN8 = WS_MTAB + al256((size_t)2 * NWG * 512 * 4);
constexpr size_t WS_WG8T = WS_XN8 + al256((size_t)R * D);
constexpr size_t WS_END = WS_WG8T + al256((size_t)4096 * 2048);
struct Params {
    const float *x, *meta, *rel_bias, *norm_mix, *w_in, *conv_w, *gate_bias, *lamp, *subln, *w_bda, *w_bm, *w_gate, *b_gate, *w_out, *norm_ffn, *w_router, *b_router, *w1, *b1, *w2, *b2, *norm_final;
    float* out; unsigned char* ws;
#define WSP(name, T, off) __device__ __host__ __forceinline__ T* name() const { return (T*)(ws + (off)); }
    WSP(ctl, unsigned, WS_CTL) WSP(cursor, int, WS_CTL + 16384)
    WSP(WinT, bf16_t, WS_WINT) WSP(WbrT, bf16_t, WS_WBRT) WSP(WoutT, bf16_t, WS_WOUTT) WSP(W1T, bf16_t, WS_W1T) WSP(W2T, bf16_t, WS_W2T)
    WSP(XN, bf16_t, WS_XN) WSP(gates, float, WS_GATES) WSP(biasP, float, WS_BIASP) WSP(P, bf16_t, WS_P) WSP(YDM, bf16_t, WS_YDM) WSP(OS, float, WS_OS) WSP(Tmix, float, WS_TMIX)
    WSP(MIX, bf16_t, WS_MIX) WSP(H1, bf16_t, WS_H1) WSP(HN, bf16_t, WS_HN) WSP(topW, float, WS_TOPW) WSP(dest, int, WS_DEST) WSP(list, int, WS_LIST) WSP(ACT, bf16_t, WS_ACT) WSP(Y, bf16_t, WS_Y)
    WSP(Qc, bf16_t, WS_QC) WSP(Kc, bf16_t, WS_KC) WSP(GB, float, WS_GB) WSP(GA, float, WS_GA) WSP(GPM, float, WS_GPM) WSP(CS, float, WS_CS) WSP(DC, float, WS_DC) WSP(DN, float, WS_DN)
    WSP(Cst, bf16_t, WS_CST) WSP(Nst, float, WS_NST) WSP(Mst, float, WS_MST) WSP(HS, float, WS_HS) WSP(mtab, int, WS_MTAB) WSP(XN8, unsigned char, WS_XN8) WSP(WG8T, unsigned char, WS_WG8T)
#undef WSP
};
struct Args { Params p; int ph_lo, ph_hi; };

__device__ __forceinline__ int tok2prow(int tok) { return (tok >> 12) * LP + PADF + NMETA + (tok & 4095); }
namespace pg8 {
constexpr int BM = 256, BK = 64, HALF = 128, HTB = HALF * BK * 2, STAGE_BYTES = 8 * HTB, NXCD = 8, WGM = 8;
__host__ __device__ __forceinline__ int lds_byte(int r, int c) { const int st = (r >> 4) * 2 + (c >> 5), rr = r & 15, cc = c & 31, ob = rr * 64 + cc * 2; return st * 1024 + (ob ^ (((ob >> 9) & 1) << 5)); }
__host__ __device__ __forceinline__ void stage_rc(int b, int& Rr, int& C) { const int st = b / 1024, sb = b % 1024, swz = sb ^ (((sb >> 9) & 1) << 5); Rr = (st >> 1) * 16 + swz / 64; C = (st & 1) * 32 + (swz % 64) / 2; }
__host__ __device__ __forceinline__ int perm32(int rho) { const int n = rho >> 4, i = rho & 15; return 8 * (i >> 2) + 4 * n + (i & 3); }
struct Unit { int a0, b0, r0, c0, aux, nv, rot, bo; };
struct PF { unsigned a, b, c, d; };
struct TileOrder {
    int nM, nN, nwg, G, c, wgm;
    __device__ void init(int nM_, int nN_, int G_, int c_, int wgm_ = WGM) { nM = nM_; nN = nN_; nwg = nM * nN; G = G_; c = c_; wgm = wgm_; }
    __device__ bool tile(int i, int& pm, int& pn) const {
        const long Lx = (long)i * G + c; if (Lx >= nwg) return false;
        int wgid = (int)Lx; { const int q = nwg / NXCD, r = nwg % NXCD, xcd = wgid % NXCD, off = wgid / NXCD; wgid = (xcd < r ? xcd * (q + 1) : r * (q + 1) + (xcd - r) * q) + off; }
        const int nig = wgm * nN, gid = wgid / nig, fm = gid * wgm, gsz = (nM - fm) < wgm ? (nM - fm) : wgm;
        pm = fm + ((wgid % nig) % gsz); pn = (wgid % nig) / gsz; return true;
    }
};
template <class Epi, class Sched, int ES = 2>
__device__ __forceinline__ void gemm_phase(LAS unsigned char* lds, const void* A, const void* Bt, const int K, const Sched& S, const Epi& E) {
    const int tid = threadIdx.x, wid = __builtin_amdgcn_readfirstlane(tid >> 6), lane = tid & 63, wr = wid >> 2, wc = wid & 3, fr = lane & 15, fq = lane >> 4;
    const int nt = K * ES / 128;
    unsigned voffA[2], voffB[2];
#pragma unroll
    for (int i = 0; i < 2; ++i) { int Rr, C; stage_rc(tid * 16 + i * 8192, Rr, C); const int Rb = Epi::PERM ? ((Rr & ~31) + perm32(Rr & 31)) : Rr;
        voffA[i] = (unsigned)(Rr * K * ES + C * 2); voffB[i] = Sched::BTILED ? (unsigned)(Rb * 128 + C * 2) : (unsigned)(Rb * K * ES + C * 2); }
    const size_t kstep = (size_t)(BK * 2);
    const size_t hstep = (size_t)HALF * K * ES;
    const size_t kstepB = Sched::BTILED ? (size_t)32768 : kstep, hstepB = Sched::BTILED ? (size_t)(HALF * 128) : hstep;
    const size_t rstep = (size_t)K * ES;
    const unsigned ldsw = (unsigned)wid * 1024u;
    const int aoff = ES == 2 ? lds_byte(wr * 64 + fr, fq * 8) : lds_byte(wr * 64 + fr, fq * 16), boff = ES == 2 ? lds_byte(wc * 32 + fr, fq * 8) : lds_byte(wc * 32 + fr, fq * 16);
#define PG8_SA(b, h) (((b) * 2 + (h)) * HTB)
#define PG8_SB(b, h) ((4 + (b) * 2 + (h)) * HTB)
#define PG8_STAGE(bufoff, gbase, voff) do { _Pragma("unroll") for (int _i = 0; _i < 2; ++_i) \
        __builtin_amdgcn_global_load_lds((const unsigned*)((const char*)(gbase) + (voff)[_i]), (LAS unsigned*)(lds + (bufoff) + ldsw + _i * 8192), 16, 0, 0); } while (0)
#define PG8_LD32(ptr) __builtin_bit_cast(i32x8, __builtin_shufflevector(*(const LAS u32x4*)(ptr), *(const LAS u32x4*)((ptr) + 16), 0, 1, 2, 3, 4, 5, 6, 7))
#define PG8_LDA(dst, b, h) do { if constexpr (ES == 2) { _Pragma("unroll") for (int m = 0; m < 4; ++m) _Pragma("unroll") for (int k = 0; k < 2; ++k) dst[m][k] = *(const LAS bf16x8*)(lds + PG8_SA(b, h) + aoff + m * 2048 + k * 1024); } \
        else { _Pragma("unroll") for (int m = 0; m < 4; ++m) dst##8[m] = PG8_LD32(lds + PG8_SA(b, h) + aoff + m * 2048); } } while (0)
#define PG8_LDB(dst, b, h) do { if constexpr (ES == 2) { _Pragma("unroll") for (int n = 0; n < 2; ++n) _Pragma("unroll") for (int k = 0; k < 2; ++k) dst[n][k] = *(const LAS bf16x8*)(lds + PG8_SB(b, h) + boff + n * 2048 + k * 1024); } \
        else { _Pragma("unroll") for (int n = 0; n < 2; ++n) dst##8[n] = PG8_LD32(lds + PG8_SB(b, h) + boff + n * 2048); } } while (0)
#define PG8_MMA(ai, bj, At, Bt_) do { int sc127_ = 127; if constexpr (ES == 1) asm volatile("" : "+v"(sc127_)); __builtin_amdgcn_s_setprio(1); if constexpr (ES == 2) { _Pragma("unroll") for (int m = 0; m < 4; ++m) _Pragma("unroll") for (int n = 0; n < 2; ++n) _Pragma("unroll") for (int k = 0; k < 2; ++k) \
        acc[ai][bj][m][n] = __builtin_amdgcn_mfma_f32_16x16x32_bf16(Bt_[n][k], At[m][k], acc[ai][bj][m][n], 0, 0, 0); } else { _Pragma("unroll") for (int m = 0; m < 4; ++m) _Pragma("unroll") for (int n = 0; n < 2; ++n) \
        asm volatile("v_mfma_scale_f32_16x16x128_f8f6f4 %0, %1, %2, %0, %3, %3 op_sel_hi:[0,0,0]" : "+v"(acc[ai][bj][m][n]) : "v"(Bt_##8[n]), "v"(At##8[m]), "v"(sc127_)); } __builtin_amdgcn_s_setprio(0); } while (0)
#define PG8_WAIT_V(n) asm volatile("s_waitcnt vmcnt(" #n ")" ::: "memory")
#define PG8_WAIT_L(n) asm volatile("s_waitcnt lgkmcnt(" #n ")" ::: "memory")
#define PG8_BAR __builtin_amdgcn_s_barrier()
#define PG8_SCHED __builtin_amdgcn_sched_barrier(0)
    Unit cur, nxt; int ui = 0;
    if (!S.next(0, cur)) return;
    f32x4 acc[2][2][4][2];
#pragma unroll
    for (int a = 0; a < 2; ++a)
#pragma unroll
        for (int b = 0; b < 2; ++b)
#pragma unroll
            for (int m = 0; m < 4; ++m)
#pragma unroll
                for (int n = 0; n < 2; ++n) acc[a][b][m][n] = (f32x4){0.f, 0.f, 0.f, 0.f};
    bf16x8 At[4][2], B0[2][2], B1[2][2]; i32x8 At8[4], B08[2], B18[2];
    unsigned vgc[2][2], vgn[2][2];
#define PG8_GOFF(dst, u) do { _Pragma("unroll") for (int _h = 0; _h < 2; ++_h) _Pragma("unroll") for (int _i = 0; _i < 2; ++_i) { int Rr, C; stage_rc(tid * 16 + _i * 8192, Rr, C); \
        dst[_h][_i] = (unsigned)((size_t)S.arow(u, _h * HALF + Rr) * (size_t)K * ES + C * 2); } } while (0)
#define PG8_STA(b, h, PTR, NEXTSEL) do { if constexpr (Sched::GATHER) { if (NEXTSEL) PG8_STAGE(PG8_SA(b, h), PTR, vgn[h]); else PG8_STAGE(PG8_SA(b, h), PTR, vgc[h]); } \
        else PG8_STAGE(PG8_SA(b, h), (PTR) + (h) * hstep, voffA); } while (0)
    const char* cA = Sched::GATHER ? (const char*)A : (const char*)A + (size_t)cur.a0 * rstep; const char* cB = (const char*)Bt + (size_t)cur.b0 * rstep;
    if constexpr (Sched::GATHER) { PG8_GOFF(vgc, cur); }
    const int ntm = nt - 1;
#define PG8_KT(u, t) ((size_t)(((t) + (u).rot) & ntm) * kstep)
#define PG8_KTB(u, t) ((size_t)(((t) + (u).rot) & ntm) * kstepB)
    PG8_STAGE(PG8_SB(0, 0), cB + PG8_KTB(cur, 0), voffB); PG8_STA(0, 0, cA + PG8_KT(cur, 0), false); PG8_STAGE(PG8_SB(0, 1), cB + hstepB + PG8_KTB(cur, 0), voffB); PG8_STA(0, 1, cA + PG8_KT(cur, 0), false);
    if (wr == 1) PG8_BAR;
    PG8_WAIT_V(4); PG8_BAR;
    PG8_STAGE(PG8_SB(1, 0), cB + PG8_KTB(cur, 1), voffB); PG8_STA(1, 0, cA + PG8_KT(cur, 1), false); PG8_STAGE(PG8_SB(1, 1), cB + hstepB + PG8_KTB(cur, 1), voffB);
    PG8_WAIT_V(6); PG8_BAR;
    const PF pf = E.prefetch(cur, tid);
    for (;;) {
        const bool has_next = S.next(ui + 1, nxt);
        const char* nA = Sched::GATHER ? cA : (has_next ? (const char*)A + (size_t)nxt.a0 * rstep : cA); const char* nB = has_next ? (const char*)Bt + (size_t)nxt.b0 * rstep : cB;
        if constexpr (Sched::GATHER) { if (has_next) { PG8_GOFF(vgn, nxt); } else {
#pragma unroll
            for (int _h = 0; _h < 2; ++_h) { vgn[_h][0] = vgc[_h][0]; vgn[_h][1] = vgc[_h][1]; } }
            asm volatile("" : "+v"(vgn[0][0]), "+v"(vgn[0][1]), "+v"(vgn[1][0]), "+v"(vgn[1][1])); }
        for (int t = 0; t < nt; t += 2) {
            const bool last = (t == nt - 2);
            const Unit& un = has_next ? nxt : cur;
            const char* a1 = cA + PG8_KT(cur, t + 1); const char* b1 = cB + PG8_KTB(cur, t + 1);
            const char* a2 = last ? nA + PG8_KT(un, 0) : cA + PG8_KT(cur, t + 2); const char* b2 = last ? nB + PG8_KTB(un, 0) : cB + PG8_KTB(cur, t + 2);
            const char* a3 = last ? nA + PG8_KT(un, 1) : cA + PG8_KT(cur, t + 3); const char* b3 = last ? nB + PG8_KTB(un, 1) : cB + PG8_KTB(cur, t + 3); (void)b1;
            PG8_LDB(B0, 0, 0); PG8_SCHED; PG8_LDA(At, 0, 0); PG8_STA(1, 1, a1, false);
            PG8_WAIT_L(8); PG8_BAR; PG8_WAIT_L(0); PG8_MMA(0, 0, At, B0); PG8_BAR; PG8_SCHED;
            PG8_LDB(B1, 0, 1); PG8_STAGE(PG8_SB(0, 0), b2, voffB);
            PG8_BAR; PG8_WAIT_L(0); PG8_MMA(0, 1, At, B1); PG8_BAR;
            PG8_LDA(At, 0, 1); PG8_STA(0, 0, a2, last);
            PG8_BAR; PG8_WAIT_L(0); PG8_MMA(1, 0, At, B0); PG8_BAR; PG8_SCHED;
            PG8_STAGE(PG8_SB(0, 1), b2 + hstepB, voffB);
            PG8_WAIT_V(6); PG8_BAR; PG8_MMA(1, 1, At, B1); PG8_BAR;
            PG8_LDB(B0, 1, 0); PG8_SCHED; PG8_LDA(At, 1, 0); PG8_STA(0, 1, a2, last);
            PG8_WAIT_L(8); PG8_BAR; PG8_WAIT_L(0); PG8_MMA(0, 0, At, B0); PG8_BAR; PG8_SCHED;
            PG8_LDB(B1, 1, 1); PG8_STAGE(PG8_SB(1, 0), b3, voffB);
            PG8_BAR; PG8_WAIT_L(0); PG8_MMA(0, 1, At, B1); PG8_BAR;
            PG8_LDA(At, 1, 1); PG8_STA(1, 0, a3, last);
            PG8_BAR; PG8_WAIT_L(0); PG8_MMA(1, 0, At, B0); PG8_BAR; PG8_SCHED;
            PG8_STAGE(PG8_SB(1, 1), b3 + hstepB, voffB);
            PG8_WAIT_V(6); PG8_BAR; PG8_MMA(1, 1, At, B1); PG8_BAR;
        }
        asm volatile("" :: "v"(pf.a), "v"(pf.b), "v"(pf.c), "v"(pf.d));
        if constexpr (ES == 1) asm volatile("s_nop 15\n\ts_nop 15" ::: "memory");
        E(acc, cur, wr, wc, fr, fq);
        if (!has_next) break;
        if (!E.keep(cur)) {
#pragma unroll
        for (int a = 0; a < 2; ++a)
#pragma unroll
            for (int b = 0; b < 2; ++b)
#pragma unroll
                for (int m = 0; m < 4; ++m)
#pragma unroll
                    for (int n = 0; n < 2; ++n) acc[a][b][m][n] = (f32x4){0.f, 0.f, 0.f, 0.f}; }
        cur = nxt; cA = nA; cB = nB; ++ui;
        if constexpr (Sched::GATHER) {
#pragma unroll
            for (int _h = 0; _h < 2; ++_h) { vgc[_h][0] = vgn[_h][0]; vgc[_h][1] = vgn[_h][1]; } }
    }
    PG8_WAIT_V(0);
    if (wr == 0) PG8_BAR;
    PG8_BAR;
#undef PG8_SA
#undef PG8_LD32
#undef PG8_KT
#undef PG8_KTB
#undef PG8_GOFF
#undef PG8_STA
#undef PG8_SB
#undef PG8_STAGE
#undef PG8_LDA
#undef PG8_LDB
#undef PG8_MMA
#undef PG8_WAIT_V
#undef PG8_WAIT_L
#undef PG8_BAR
#undef PG8_SCHED
}
}

struct SchedProj { static constexpr bool BTILED = false; static constexpr bool GATHER = false; pg8::TileOrder T;
    __device__ int arow(const pg8::Unit&, int) const { return 0; }
    __device__ bool next(int i, pg8::Unit& u) const { int pm, pn; if (!T.tile(i, pm, pn)) return false; u.a0 = tok2prow(pm * 256); u.b0 = pn * 256; u.r0 = u.a0; u.c0 = pn * 256; u.aux = 0; u.nv = 256; u.rot = 0; return true; } };
struct EpiProj { __device__ __forceinline__ pg8::PF prefetch(const pg8::Unit&, int) const { return pg8::PF{0u, 0u, 0u, 0u}; } __device__ __forceinline__ bool keep(const pg8::Unit&) const { return false; } static constexpr bool PERM = true; bf16_t* P; const float* bias; float scale;
    __device__ __forceinline__ void operator()(f32x4 (&acc)[2][2][4][2], const pg8::Unit& u, int wr, int wc, int fr, int fq) const {
        const int row0 = u.r0 + wr * 64 + fr, col0 = u.c0 + wc * 32 + 8 * fq; const bool sig = u.c0 >= 6144;
        f32x4 bv[2][2];
#pragma unroll
        for (int bj = 0; bj < 2; ++bj)
#pragma unroll
            for (int n = 0; n < 2; ++n) bv[bj][n] = sig ? *(const f32x4*)(bias + col0 + bj * 128 + 4 * n) : (f32x4){0.f, 0.f, 0.f, 0.f};
#pragma unroll
        for (int ai = 0; ai < 2; ++ai)
#pragma unroll
            for (int m = 0; m < 4; ++m) { bf16_t* rowp = P + (size_t)(row0 + ai * 128 + m * 16) * NPROJ + col0;
#pragma unroll
                for (int bj = 0; bj < 2; ++bj) { f32x4 v0 = acc[ai][bj][m][0] * scale + bv[bj][0], v1 = acc[ai][bj][m][1] * scale + bv[bj][1];
                    if (sig) {
#pragma unroll
                        for (int j = 0; j < 4; ++j) { v0[j] = __builtin_amdgcn_rcpf(1.0f + __expf(-v0[j])); v1[j] = __builtin_amdgcn_rcpf(1.0f + __expf(-v1[j])); } }
                    u32x4 w; w.x = cvt_pk_bf16(v0[0], v0[1]); w.y = cvt_pk_bf16(v0[2], v0[3]); w.z = cvt_pk_bf16(v1[0], v1[1]); w.w = cvt_pk_bf16(v1[2], v1[3]);
                    *(u32x4*)(rowp + bj * 128) = w; } }
    }
};


struct SchedGate8 { static constexpr bool BTILED = true; static constexpr bool GATHER = false; pg8::TileOrder T;
    __device__ bool next(int i, pg8::Unit& u) const { int pm, pn; if (!T.tile(i, pm, pn)) return false; u.a0 = tok2prow(pm * 256); u.b0 = pn * 256; u.r0 = u.a0; u.c0 = 6144 + pn * 256; u.aux = 0; u.nv = 256; u.rot = 0; return true; }
    __device__ int arow(const pg8::Unit&, int) const { return 0; } };

__device__ __forceinline__ void proj_meta(const Params& p, const int task, float* red) {
    const int tid = otid(), wid = tid >> 6, lane = tid & 63, r16 = lane & 15, g = lane >> 4, c0 = 1024 + task * 32;
    const bf16_t* ap = p.XN() + (size_t)(PADF + r16) * D + wid * 256 + 8 * g;
    const bf16_t* bp0 = p.WinT() + (size_t)(c0 + r16) * D + wid * 256 + 8 * g; const bf16_t* bp1 = bp0 + (size_t)16 * D;
    bf16x8 a[8], b0[8], b1[8];
#pragma unroll
    for (int ks = 0; ks < 8; ++ks) { a[ks] = *reinterpret_cast<const bf16x8*>(ap + ks * 32); b0[ks] = *reinterpret_cast<const bf16x8*>(bp0 + ks * 32); b1[ks] = *reinterpret_cast<const bf16x8*>(bp1 + ks * 32); }
    f32x4 acc0 = {0.f, 0.f, 0.f, 0.f}, acc1 = {0.f, 0.f, 0.f, 0.f};
#pragma unroll
    for (int ks = 0; ks < 8; ++ks) { acc0 = __builtin_amdgcn_mfma_f32_16x16x32_bf16(a[ks], b0[ks], acc0, 0, 0, 0); acc1 = __builtin_amdgcn_mfma_f32_16x16x32_bf16(a[ks], b1[ks], acc1, 0, 0, 0); }
    *(f32x4*)(red + ((wid * 2 + 0) * 64 + lane) * 4) = acc0; *(f32x4*)(red + ((wid * 2 + 1) * 64 + lane) * 4) = acc1;
    __syncthreads();
    { const int l2 = tid & 63, blk = (tid >> 6) & 1, reg = tid >> 7; float v = 0.f;
#pragma unroll
      for (int w = 0; w < 8; ++w) v += red[((w * 2 + blk) * 64 + l2) * 4 + reg];
      const int row = PADF + 4 * (l2 >> 4) + reg, col = c0 + 16 * blk + (l2 & 15); const bf16_t o = (bf16_t)(cvt_pk_bf16(v, 0.f) & 0xffffu);
#pragma unroll
      for (int b = 0; b < NB; ++b) p.P()[(size_t)(b * LP + row) * NPROJ + col] = o; }
    __syncthreads();
}

struct CvtTile { const float* src; bf16_t* dst; int ld, K, f8; };
constexpr int CVT_NT = 1536 + 1024 + 512 + 512 + 32768 + 16384;
__device__ __forceinline__ CvtTile cvt_desc(const Params& p, int t) {
    CvtTile d;
    if (t < 1536) { const int nt = t / 16, kt = t % 16; d.src = p.w_in + (size_t)kt * 128 * INC + nt * 64; d.dst = p.WinT() + (size_t)(nt * 64) * 2048 + kt * 128; d.ld = INC; d.K = 2048; d.f8 = 0; return d; }
    t -= 1536;
    if (t < 1024) { const int nt = t / 16, kt = t % 16; d.src = p.w_gate + (size_t)kt * 128 * 4096 + nt * 64; d.dst = (bf16_t*)(p.WG8T() + ((size_t)(nt >> 2) * 16 + kt) * 32768 + (nt & 3) * 8192); d.ld = 4096; d.K = 128; d.f8 = 1; return d; }
    t -= 1024;
    if (t < 512) { const int which = t / 256, t2 = t % 256, nt = t2 / 8, kt = t2 % 8; d.src = (which ? p.w_bm : p.w_bda) + (size_t)kt * 128 * 2048 + nt * 64; d.dst = p.WbrT() + (size_t)(which * 2048 + nt * 64) * 1024 + kt * 128; d.ld = 2048; d.K = 1024; d.f8 = 0; return d; }
    t -= 512;
    if (t < 512) { const int nt = t / 16, kt = t % 16; d.src = p.w_out + (size_t)kt * 128 * 2048 + nt * 64; d.dst = p.WoutT() + (size_t)(nt * 64) * 2048 + kt * 128; d.ld = 2048; d.K = 2048; d.f8 = 0; return d; }
    t -= 512;
    if (t < 32768) { const int e = t / 1024, t2 = t % 1024, nt = t2 / 16, kt = t2 % 16, blk = nt / 4, w0 = (nt % 4) * 64; const int scol = w0 < 128 ? blk * 128 + w0 : 2048 + blk * 128 + (w0 - 128);
        d.src = p.w1 + (size_t)e * 2048 * 4096 + (size_t)kt * 128 * 4096 + scol; d.dst = (bf16_t*)((unsigned char*)p.W1T() + ((size_t)(e * 16 + (nt >> 2)) * 16 + kt) * 32768 + (nt & 3) * 8192); d.ld = 4096; d.K = 128; d.f8 = 1; return d; }
    t -= 32768;
    { const int e = t / 512, t2 = t % 512, nt = t2 / 16, kt = t2 % 16; d.src = p.w2 + (size_t)e * 2048 * 2048 + (size_t)kt * 128 * 2048 + nt * 64; d.dst = (bf16_t*)((unsigned char*)p.W2T() + ((size_t)(e * 8 + (nt >> 2)) * 16 + kt) * 32768 + (nt & 3) * 8192); d.ld = 2048; d.K = 128; d.f8 = 1; return d; }
}

__device__ __forceinline__ CvtTile cvt_moe(const Params& p, int u, const int j) {
    CvtTile d; d.K = 128; d.f8 = 1;
    if (u < 8192) { const int c = u & 15, kt = (u >> 4) & 15, e = u >> 8, blk = 2 * (c & 7) + (j >> 1), nt = blk * 4 + (j & 1) + (c >= 8 ? 2 : 0);
        d.src = p.w1 + (size_t)e * 2048 * 4096 + (size_t)kt * 128 * 4096 + c * 256 + j * 64; d.dst = (bf16_t*)((unsigned char*)p.W1T() + ((size_t)(e * 16 + (nt >> 2)) * 16 + kt) * 32768 + (nt & 3) * 8192); d.ld = 4096; return d; }
    u -= 8192;
    { const int c = u & 7, kt = (u >> 3) & 15, e = u >> 7, nt = c * 4 + j;
        d.src = p.w2 + (size_t)e * 2048 * 2048 + (size_t)kt * 128 * 2048 + nt * 64; d.dst = (bf16_t*)((unsigned char*)p.W2T() + ((size_t)(e * 8 + (nt >> 2)) * 16 + kt) * 32768 + (nt & 3) * 8192); d.ld = 2048; return d; }
}
__device__ __forceinline__ void convert_ring(const Params& p, unsigned char* lds_, const int first, const int stride) {
    LAS unsigned char* lds = (LAS unsigned char*)lds_;
    const int tid = otid(), wid = __builtin_amdgcn_readfirstlane(tid >> 6), lk = tid >> 4, lq = tid & 15;
    constexpr int NSUP = 8192 + 4096;
    const int ntile = 4 * ((NSUP - first + stride - 1) / stride);
#define RING_ISSUE(i_, slot_) do { const CvtTile d_ = cvt_moe(p, first + ((i_) >> 2) * stride, (i_) & 3); _Pragma("unroll") for (int r_ = 0; r_ < 4; ++r_) { const int k_ = lk + 32 * r_; \
        __builtin_amdgcn_global_load_lds((const unsigned*)(d_.src + (size_t)k_ * d_.ld + ((lq ^ ((k_ >> 4) & 7)) << 2)), (LAS unsigned*)(lds + (slot_) * 32768 + (wid * 4 + 32 * r_) * 256), 16, 0, 2  ); } } while (0)
    if (ntile > 0) RING_ISSUE(0, 0);
    if (ntile > 1) RING_ISSUE(1, 1);
    if (ntile > 2) RING_ISSUE(2, 2);
    const int n = tid >> 3, kc = tid & 7;
    for (int it = 0; it < ntile; ++it) {
        if (it + 3 < ntile) { RING_ISSUE(it + 3, (it + 3) & 3); asm volatile("s_waitcnt vmcnt(12)" ::: "memory"); }
        else asm volatile("s_waitcnt vmcnt(0)" ::: "memory");
        __builtin_amdgcn_s_barrier();
        const CvtTile d = cvt_moe(p, first + (it >> 2) * stride, it & 3);
        const LAS float* qq = (const LAS float*)(lds + (it & 3) * 32768) + (kc * 16) * 64 + ((((n >> 2) ^ kc) << 2) | (n & 3));
        float v[16];
#pragma unroll
        for (int j = 0; j < 16; ++j) v[j] = qq[j * 64];
        asm volatile("s_waitcnt lgkmcnt(0)" ::: "memory");
        __builtin_amdgcn_s_barrier();
        u32x4 w; w.x = pk4_fp8(v[0] * W8_SCALE, v[1] * W8_SCALE, v[2] * W8_SCALE, v[3] * W8_SCALE); w.y = pk4_fp8(v[4] * W8_SCALE, v[5] * W8_SCALE, v[6] * W8_SCALE, v[7] * W8_SCALE);
        w.z = pk4_fp8(v[8] * W8_SCALE, v[9] * W8_SCALE, v[10] * W8_SCALE, v[11] * W8_SCALE); w.w = pk4_fp8(v[12] * W8_SCALE, v[13] * W8_SCALE, v[14] * W8_SCALE, v[15] * W8_SCALE);
        *(u32x4*)((unsigned char*)d.dst + (size_t)n * d.K + kc * 16) = w;
    }
    asm volatile("s_waitcnt vmcnt(0)" ::: "memory");
#undef RING_ISSUE
}
__device__ __forceinline__ void phase0(const Params& p, unsigned char* lds) {
    const int tid = otid(), wid = tid >> 6, lane = tid & 63;
    {
        float* WgT = (float*)lds;
        for (int i = tid; i < 2048 * 4; i += 512) { const int k = i >> 2, q = i & 3; const float4 w4 = *(const float4*)(p.w_in + (size_t)k * INC + 6144 + q * 4);
            WgT[(q * 4 + 0) * 2048 + k] = w4.x; WgT[(q * 4 + 1) * 2048 + k] = w4.y; WgT[(q * 4 + 2) * 2048 + k] = w4.z; WgT[(q * 4 + 3) * 2048 + k] = w4.w; }
        for (int i = blockIdx.x * 512 + tid; i < NPROJ; i += gridDim.x * 512) p.biasP()[i] = i < 6144 ? 0.f : p.b_gate[i - 6144];
        __syncthreads();
        const int rstride = gridDim.x * 8; float4 vn[8];
#define P0_SRC(rr) (((rr) % LP) >= PADF + NMETA ? p.x + ((size_t)((rr) / LP) * SEQ + (((rr) % LP) - PADF - NMETA)) * D : p.meta + (size_t)(((rr) % LP) - PADF) * D)
        { const int r0 = blockIdx.x * 8 + wid; if (r0 < R && (r0 % LP) >= PADF) { const float* s0 = P0_SRC(r0);
#pragma unroll
            for (int q = 0; q < 8; ++q) vn[q] = *(const float4*)(s0 + q * 256 + lane * 4); } }
        for (int r = blockIdx.x * 8 + wid; r < R; r += rstride) {
            const int pp = r % LP;
            float4 v[8]; float ss = 0.f;
#pragma unroll
            for (int q = 0; q < 8; ++q) v[q] = vn[q];
            { const int rn = r + rstride; if (rn < R && (rn % LP) >= PADF) { const float* s1 = P0_SRC(rn);
#pragma unroll
                for (int q = 0; q < 8; ++q) vn[q] = *(const float4*)(s1 + q * 256 + lane * 4); } }
            if (pp < PADF) {
#pragma unroll
                for (int q = 0; q < 8; ++q) { *(u32x2*)(p.XN() + (size_t)r * D + q * 256 + lane * 4) = (u32x2){0u, 0u}; *(unsigned*)(p.XN8() + (size_t)r * D + q * 256 + lane * 4) = 0u; }
                if (lane < 16) p.gates()[(size_t)r * 16 + lane] = 0.f;
                continue; }
#pragma unroll
            for (int q = 0; q < 8; ++q) ss += v[q].x * v[q].x + v[q].y * v[q].y + v[q].z * v[q].z + v[q].w * v[q].w;
            ss = wave_sum(ss); const float rs = rsqrtf(ss / D + EPS);
            float ga[16];
#pragma unroll
            for (int g = 0; g < 16; ++g) ga[g] = 0.f;
#pragma unroll
            for (int q = 0; q < 8; ++q) { const int c = q * 256 + lane * 4; const float4 gn = *(const float4*)(p.norm_mix + c);
                const float x0 = v[q].x * rs * gn.x, x1 = v[q].y * rs * gn.y, x2 = v[q].z * rs * gn.z, x3 = v[q].w * rs * gn.w;
                u32x2 w; w.x = cvt_pk_bf16(x0, x1); w.y = cvt_pk_bf16(x2, x3); *(u32x2*)(p.XN() + (size_t)r * D + c) = w; *(unsigned*)(p.XN8() + (size_t)r * D + c) = pk4_fp8(x0, x1, x2, x3);
#pragma unroll
                for (int g = 0; g < 16; ++g) { const float4 w4 = *(const float4*)(WgT + g * 2048 + c); ga[g] += x0 * w4.x + x1 * w4.y + x2 * w4.z + x3 * w4.w; } }
            float a8[8], a4[4], a2[2];
            { const bool hb = (lane >> 5) & 1;
#pragma unroll
              for (int i = 0; i < 8; ++i) { const float x = hb ? ga[i + 8] : ga[i], y = hb ? ga[i] : ga[i + 8]; a8[i] = x + __shfl_xor(y, 32); } }
            { const bool hb = (lane >> 4) & 1;
#pragma unroll
              for (int i = 0; i < 4; ++i) { const float x = hb ? a8[i + 4] : a8[i], y = hb ? a8[i] : a8[i + 4]; a4[i] = x + __shfl_xor(y, 16); } }
            { const bool hb = (lane >> 3) & 1;
#pragma unroll
              for (int i = 0; i < 2; ++i) { const float x = hb ? a4[i + 2] : a4[i], y = hb ? a4[i] : a4[i + 2]; a2[i] = x + __shfl_xor(y, 8); } }
            float a1; { const bool hb = (lane >> 2) & 1; const float x = hb ? a2[1] : a2[0], y = hb ? a2[0] : a2[1]; a1 = x + __shfl_xor(y, 4); }
            a1 += __shfl_xor(a1, 2); a1 += __shfl_xor(a1, 1);
            if ((lane & 3) == 0) p.gates()[(size_t)r * 16 + (lane >> 2)] = a1;
        }
#undef P0_SRC
        __syncthreads();
    }
    {
        float* T = (float*)lds;
        const int lk = tid >> 4, lq = tid & 15;
        f32x4 cur[4][4], nxt[4][4];
#define CVT_LOAD(buf, g) do { _Pragma("unroll") for (int q = 0; q < 4; ++q) { const CvtTile d = cvt_desc(p, (g) * 4 + q); _Pragma("unroll") for (int i = 0; i < 4; ++i) \
            buf[q][i] = __builtin_nontemporal_load((const f32x4*)(d.src + (size_t)(lk + 32 * i) * d.ld + lq * 4)); } } while (0)
        int g = blockIdx.x;
        constexpr int G_HI = P1_WORKERS == NWG ? CVT_NT / 4 : (1536 + 1024 + 512 + 512) / 4;
        if (g < G_HI) CVT_LOAD(cur, g);
        for (; g < G_HI; g += gridDim.x) {
            const int gn = g + gridDim.x;
            if (gn < G_HI) CVT_LOAD(nxt, gn);
#pragma unroll
            for (int q = 0; q < 4; ++q)
#pragma unroll
                for (int i = 0; i < 4; ++i) { float* q0 = T + q * (128 * 65) + (lk + 32 * i) * 65 + lq * 4; q0[0] = cur[q][i][0]; q0[1] = cur[q][i][1]; q0[2] = cur[q][i][2]; q0[3] = cur[q][i][3]; }
            __syncthreads();
#pragma unroll
            for (int q = 0; q < 4; ++q) { const CvtTile d = cvt_desc(p, g * 4 + q);
                if (d.f8) { const int n = tid >> 3, kc = tid & 7; const float* qq = T + q * (128 * 65) + (kc * 16) * 65 + n; u32x4 w;
                    w.x = pk4_fp8(qq[0] * W8_SCALE, qq[65] * W8_SCALE, qq[130] * W8_SCALE, qq[195] * W8_SCALE); w.y = pk4_fp8(qq[260] * W8_SCALE, qq[325] * W8_SCALE, qq[390] * W8_SCALE, qq[455] * W8_SCALE);
                    w.z = pk4_fp8(qq[520] * W8_SCALE, qq[585] * W8_SCALE, qq[650] * W8_SCALE, qq[715] * W8_SCALE); w.w = pk4_fp8(qq[780] * W8_SCALE, qq[845] * W8_SCALE, qq[910] * W8_SCALE, qq[975] * W8_SCALE);
                    *(u32x4*)((unsigned char*)d.dst + (size_t)n * d.K + kc * 16) = w;
                } else {
#pragma unroll
                for (int i = 0; i < 2; ++i) { const int ch = tid + 512 * i, n = ch >> 4, kc = ch & 15; const float* qq = T + q * (128 * 65) + (kc * 8) * 65 + n;
                    u32x4 w; w.x = cvt_pk_bf16(qq[0], qq[65]); w.y = cvt_pk_bf16(qq[130], qq[195]); w.z = cvt_pk_bf16(qq[260], qq[325]); w.w = cvt_pk_bf16(qq[390], qq[455]);
                    *(u32x4*)(d.dst + (size_t)n * d.K + kc * 8) = w; } } }
            __syncthreads();
#pragma unroll
            for (int q = 0; q < 4; ++q)
#pragma unroll
                for (int i = 0; i < 4; ++i) cur[q][i] = nxt[q][i];
        }
#undef CVT_LOAD
    }
}


namespace att {
constexpr int QBLK = 32, KVBLK = 64, NW = 8;
constexpr float SCALE = 0.088388347648318440f, THR = 8.f;
constexpr int LDQ = NPROJ, LDK = NPROJ;
constexpr int SHM_V = KVBLK * 128 * 2, SHM_K = KVBLK * 128 * 2, SHM_ATTN = 2 * SHM_V + 2 * SHM_K + NW * 64 * 4;
constexpr int TAB_B = SHM_ATTN;
using s16x4 = __attribute__((ext_vector_type(4))) short;
using f32x16 = __attribute__((ext_vector_type(16))) float;
#define KSWZ(row, colB) ((row) * 256 + ((colB) ^ (((row) & 7) << 4)))
#define SBAR() __builtin_amdgcn_sched_barrier(0)
__device__ __forceinline__ int crow(int r, int hi) { return (r & 3) + 8 * (r >> 2) + 4 * hi; }
__device__ __forceinline__ void partialSM(f32x16& p0, f32x16& p1, float& m_reg, float& mn, float& alpha, const float cadd) {
  constexpr float C = SCALE * 1.4426950408889634f;
  float pmax = p0[0]; for (int r = 1; r < 16; ++r) pmax = fmaxf(pmax, p0[r]); for (int r = 0; r < 16; ++r) pmax = fmaxf(pmax, p1[r]);
  { auto rr = __builtin_amdgcn_permlane32_swap(__float_as_uint(pmax), __float_as_uint(pmax), false, false);
    pmax = fmaxf(__uint_as_float(rr[0]), __uint_as_float(rr[1])); }
  pmax += cadd;
  if (__builtin_expect(__all(pmax - m_reg <= THR / SCALE), 1)) { mn = m_reg; alpha = 1.f; }
  else { mn = fmaxf(m_reg, pmax); alpha = __builtin_amdgcn_exp2f((m_reg - mn) * C); m_reg = mn; }
  float mnC = (cadd - mn) * C;
  for (int r = 0; r < 16; ++r) p0[r] = fmaf(p0[r], C, mnC); for (int r = 0; r < 16; ++r) p1[r] = fmaf(p1[r], C, mnC);
  for (int r = 0; r < 16; ++r) p0[r] = __builtin_amdgcn_exp2f(p0[r]);
}
__device__ __forceinline__ void finishSM(f32x16& p0, f32x16& p1, float alpha, float& l_reg, bf16x8& pa0, bf16x8& pa1, bf16x8& pa2, bf16x8& pa3) {
  for (int r = 0; r < 16; ++r) p1[r] = __builtin_amdgcn_exp2f(p1[r]);
  float ps = 0; for (int r = 0; r < 16; ++r) ps += p0[r]; for (int r = 0; r < 16; ++r) ps += p1[r];
  { auto rr = __builtin_amdgcn_permlane32_swap(__float_as_uint(ps), __float_as_uint(ps), false, false);
    ps = __uint_as_float(rr[0]) + __uint_as_float(rr[1]); }
  l_reg = l_reg * alpha + ps;
#define PK4(P, BASE, OUT) do { unsigned a0 = cvt_pk_bf16(P[BASE + 0], P[BASE + 1]), a1 = cvt_pk_bf16(P[BASE + 2], P[BASE + 3]);   \
    unsigned b0 = cvt_pk_bf16(P[BASE + 4], P[BASE + 5]), b1 = cvt_pk_bf16(P[BASE + 6], P[BASE + 7]);                              \
    auto r0 = __builtin_amdgcn_permlane32_swap(a0, b0, false, false); auto r1 = __builtin_amdgcn_permlane32_swap(a1, b1, false, false); \
    u32x4 w = {r0[0], r1[0], r0[1], r1[1]}; OUT = *reinterpret_cast<bf16x8*>(&w); } while (0)
  PK4(p0, 0, pa0); PK4(p0, 8, pa1); PK4(p1, 0, pa2); PK4(p1, 8, pa3);
#undef PK4
}
__device__ __forceinline__ void qkt(f32x16& p0, f32x16& p1, const bf16_t* Ks, const bf16x8* qr, int r32, int hi) {
  p0 = f32x16{}; p1 = f32x16{};
  for (int d0 = 0; d0 < 8; ++d0) { int cb = (d0 * 16 + hi * 8) * 2;
    bf16x8 b0 = *reinterpret_cast<const bf16x8*>((const char*)Ks + KSWZ(r32, cb));
    bf16x8 b1 = *reinterpret_cast<const bf16x8*>((const char*)Ks + KSWZ(32 + r32, cb));
    p0 = __builtin_amdgcn_mfma_f32_32x32x16_bf16(b0, qr[d0], p0, 0, 0, 0);
    p1 = __builtin_amdgcn_mfma_f32_32x32x16_bf16(b1, qr[d0], p1, 0, 0, 0); }
}
__device__ __forceinline__ int v_st(int k, int c) { const int kk = (k & ~0xC) | ((k & 4) << 1) | ((k & 8) >> 1); return ((kk >> 3) * 4 + (c >> 5)) * 512 + ((kk & 7) * 32 + (c & 31)) * 2; }
__device__ __forceinline__ int v_rd_base(int lane) { return ((lane & 3) << 3) | (((lane >> 2) & 3) << 6) | (((lane >> 4) & 1) << 5) | (((lane >> 5) & 1) << 8); }
constexpr int v_rd_off(int d0, int ks, int half) { return d0 * 512 + ks * 4096 + half * 2048; }
template <int OFF> __device__ __forceinline__ s16x4 tr_read(int vb) {
  s16x4 r; asm volatile("ds_read_b64_tr_b16 %0, %1 offset:%2" : "=&v"(r) : "v"(vb), "i"(OFF) : "memory"); return r;
}
template <int D0> __device__ __forceinline__ void pv_one(f32x16& od, int vb, bf16x8 pa0, bf16x8 pa1, bf16x8 pa2, bf16x8 pa3) {
  const s16x4 l0 = tr_read<v_rd_off(D0, 0, 0)>(vb), h0 = tr_read<v_rd_off(D0, 0, 1)>(vb), l1 = tr_read<v_rd_off(D0, 1, 0)>(vb), h1 = tr_read<v_rd_off(D0, 1, 1)>(vb);
  const s16x4 l2 = tr_read<v_rd_off(D0, 2, 0)>(vb), h2 = tr_read<v_rd_off(D0, 2, 1)>(vb), l3 = tr_read<v_rd_off(D0, 3, 0)>(vb), h3 = tr_read<v_rd_off(D0, 3, 1)>(vb);
  asm volatile("s_waitcnt lgkmcnt(0)" ::: "memory"); SBAR();
#define PK(L, H) (bf16x8){L[0], L[1], L[2], L[3], H[0], H[1], H[2], H[3]}
  od = __builtin_amdgcn_mfma_f32_32x32x16_bf16(pa0, PK(l0, h0), od, 0, 0, 0);
  od = __builtin_amdgcn_mfma_f32_32x32x16_bf16(pa1, PK(l1, h1), od, 0, 0, 0);
  od = __builtin_amdgcn_mfma_f32_32x32x16_bf16(pa2, PK(l2, h2), od, 0, 0, 0);
  od = __builtin_amdgcn_mfma_f32_32x32x16_bf16(pa3, PK(l3, h3), od, 0, 0, 0);
#undef PK
}
__device__ __forceinline__ void pv_d0(f32x16* o, int vb, bf16x8 pa0, bf16x8 pa1, bf16x8 pa2, bf16x8 pa3) {
  pv_one<0>(o[0], vb, pa0, pa1, pa2, pa3); pv_one<1>(o[1], vb, pa0, pa1, pa2, pa3); pv_one<2>(o[2], vb, pa0, pa1, pa2, pa3); pv_one<3>(o[3], vb, pa0, pa1, pa2, pa3);
}
__device__ __forceinline__ float tile_bias(f32x16& p0, f32x16& p1, const int kt, const int q0w, const int r32, const int hi, const float* tab) {
  const int k0 = kt * KVBLK;
  if (kt >= 2) { if (k0 + 63 - q0w <= -91) return tab[0]; if (k0 - (q0w + 31) >= 91) return tab[182]; }
  const int d0 = k0 + 4 * hi - (q0w + r32) + 91, m01 = kt <= 1 ? 183 : 0, m0 = kt == 0 ? 183 : 0;
#pragma unroll
  for (int r = 0; r < 16; ++r) { const int i0 = max(min(max(d0 + (r & 3) + 8 * (r >> 2), 0), 182), m01), i1 = max(min(max(d0 + 32 + (r & 3) + 8 * (r >> 2), 0), 182), r < 8 ? m01 : m0);
    p0[r] += tab[i0]; p1[r] += tab[i1]; }
  return 0.f;
}
__device__ __forceinline__ void attn_pass(const int PASS, const bf16_t* __restrict__ Qb, const bf16_t* __restrict__ Kh, const bf16_t* __restrict__ Vh, float* __restrict__ Ob, const int q0, char* lds) {
  int tid_ = threadIdx.x; asm volatile("" : "+v"(tid_));
  const int tid = tid_, wid = tid >> 6, lane = tid & 63, r32 = lane & 31, hi = lane >> 5;
  bf16_t* V_lds = (bf16_t*)lds; bf16_t* K_lds = (bf16_t*)(lds + 2 * SHM_V);
  float* ws = (float*)(lds + 2 * SHM_V + 2 * SHM_K) + wid * 64; float* li_l = ws; float* al_l = ws + 32;
  const float* tab = (const float*)(lds + TAB_B);
  const int q0w = q0 + wid * QBLK;
  float m_reg = -1e30f, l_reg = 0; f32x16 o[4] = {}; bf16x8 qr[8];
  const bf16_t* Qw = Qb + (long)(wid * QBLK + r32) * LDQ + hi * 8;
#pragma unroll
  for (int d0 = 0; d0 < 8; ++d0) qr[d0] = *reinterpret_cast<const bf16x8*>(Qw + d0 * 16);
  const int sr = tid >> 4, sc = (tid & 15) * 8, vst0 = v_st(sr, sc), vst1 = v_st(32 + sr, sc);
  const int vb0 = (int)(uintptr_t)V_lds + v_rd_base(lane);
  const unsigned loff = (unsigned)(sr * LDK + sc) * 2u;
  struct { bf16x8 vs0, vs1, ks0, ks1; } sr_[1];
#define SLOAD(i, k0) do { const char* vb_ = (const char*)Vh + (size_t)(k0) * (LDK * 2); const char* kb_ = (const char*)Kh + (size_t)(k0) * (LDK * 2); \
    sr_[i].vs0 = *reinterpret_cast<const bf16x8*>(vb_ + loff); sr_[i].vs1 = *reinterpret_cast<const bf16x8*>(vb_ + 32 * LDK * 2 + loff); \
    sr_[i].ks0 = *reinterpret_cast<const bf16x8*>(kb_ + loff); sr_[i].ks1 = *reinterpret_cast<const bf16x8*>(kb_ + 32 * LDK * 2 + loff); } while (0)
#define SWRITE(b, i) do { *(bf16x8*)((char*)V_lds + (b) * SHM_V + vst0) = sr_[i].vs0;          \
    *(bf16x8*)((char*)V_lds + (b) * SHM_V + vst1) = sr_[i].vs1; int kc = sc * 2;               \
    *(bf16x8*)((char*)K_lds + (b) * SHM_K + KSWZ(sr, kc)) = sr_[i].ks0;                       \
    *(bf16x8*)((char*)K_lds + (b) * SHM_K + KSWZ(32 + sr, kc)) = sr_[i].ks1; } while (0)
#define SWAIT() asm volatile("s_waitcnt vmcnt(0)" ::: "memory")
#define RESC(a) do { if (__any((a) < 1.f)) { if (hi == 0) al_l[r32] = (a); asm volatile("s_waitcnt lgkmcnt(0)" ::: "memory"); \
    for (int d = 0; d < 4; ++d) for (int r = 0; r < 16; ++r) o[d][r] *= al_l[crow(r, hi)]; } } while (0)
  f32x16 pA0, pA1, pB0, pB1; float mnA, mnB, alA, alB; bf16x8 pa0, pa1, pa2, pa3; int NT = LP / KVBLK; asm volatile("" : "+s"(NT));
  constexpr int SE = 0, SO = 0;
  SLOAD(SE, 0); asm volatile("s_waitcnt vmcnt(0)" ::: "memory"); SWRITE(0, SE); __syncthreads();
  qkt(pA0, pA1, K_lds, qr, r32, hi); { const float ca = tile_bias(pA0, pA1, 0, q0w, r32, hi, tab); partialSM(pA0, pA1, m_reg, mnA, alA, ca); }
  SLOAD(SO, KVBLK);
  SWAIT(); SWRITE(1, SO); __syncthreads();
  for (int j = 1; j + 1 < NT; j += 2) {
    SBAR(); qkt(pB0, pB1, (bf16_t*)((char*)K_lds + SHM_K), qr, r32, hi);
    finishSM(pA0, pA1, alA, l_reg, pa0, pa1, pa2, pa3); SBAR();
    SLOAD(SO, (j + 1) * KVBLK); SBAR();
    pv_d0(o, vb0, pa0, pa1, pa2, pa3); { const float cb = tile_bias(pB0, pB1, j, q0w, r32, hi, tab); partialSM(pB0, pB1, m_reg, mnB, alB, cb); }
    __syncthreads(); SWAIT(); SWRITE(0, SE);
    RESC(alB); __syncthreads();
    SBAR(); qkt(pA0, pA1, K_lds, qr, r32, hi);
    finishSM(pB0, pB1, alB, l_reg, pa0, pa1, pa2, pa3); SBAR();
    SLOAD(SE, (j + 2) * KVBLK); SBAR();
    pv_d0(o, vb0 + (int)SHM_V, pa0, pa1, pa2, pa3); { const float ca = tile_bias(pA0, pA1, j + 1, q0w, r32, hi, tab); partialSM(pA0, pA1, m_reg, mnA, alA, ca); }
    __syncthreads(); SWAIT(); SWRITE(1, SO);
    RESC(alA); __syncthreads();
  }
  SBAR(); qkt(pB0, pB1, (bf16_t*)((char*)K_lds + SHM_K), qr, r32, hi);
  finishSM(pA0, pA1, alA, l_reg, pa0, pa1, pa2, pa3); SBAR();
  pv_d0(o, vb0, pa0, pa1, pa2, pa3); { const float cb = tile_bias(pB0, pB1, NT - 1, q0w, r32, hi, tab); partialSM(pB0, pB1, m_reg, mnB, alB, cb); }
  __syncthreads(); RESC(alB);
  finishSM(pB0, pB1, alB, l_reg, pa0, pa1, pa2, pa3); SBAR();
  pv_d0(o, vb0 + (int)SHM_V, pa0, pa1, pa2, pa3);
  if (hi == 0) li_l[r32] = l_reg; asm volatile("s_waitcnt lgkmcnt(0)" ::: "memory");
  float rli[16];
#pragma unroll
  for (int r = 0; r < 16; ++r) rli[r] = __builtin_amdgcn_rcpf(li_l[crow(r, hi)]);
  const float lam = tab[184];
  float* Ow = Ob + (long)(wid * QBLK) * 1024 + r32;
  { const float osc = PASS ? lam : 1.0f;
#pragma unroll
    for (int r = 0; r < 16; ++r) { const int orow = crow(r, hi); const float f = rli[r] * osc;
#pragma unroll
      for (int d0 = 0; d0 < 4; ++d0) Ow[(long)orow * 1024 + d0 * 32] = o[d0][r] * f; } }
  __syncthreads();
#undef SLOAD
#undef SWRITE
#undef SWAIT
#undef RESC
}
#undef KSWZ
#undef SBAR
}
__device__ __forceinline__ void phase_attn(const Params& p, unsigned char* lds_) {
    char* lds = (char*)lds_; float* tab = (float*)(lds + att::TAB_B);
    const int tid = otid();
    for (int it = blockIdx.x; it < 256; it += gridDim.x) {
        const int g = (it & 7) * 2 + ((it >> 3) >> 4), qb = (it >> 3) & 15, b = g >> 3, h = (g >> 1) & 3, dvh = g & 1;
        if (tid < 183) tab[tid] = p.rel_bias[t5_bucket(tid - 91) * 4 + h] * (1.0f / att::SCALE); else if (tid == 183) tab[183] = -1e30f;
        if (tid >= 448) { const int l = tid - 448; float a = p.lamp[l] * p.lamp[128 + l] + p.lamp[64 + l] * p.lamp[192 + l], c = p.lamp[256 + l] * p.lamp[384 + l] + p.lamp[320 + l] * p.lamp[448 + l];
            a = wave_sum(a); c = wave_sum(c); if (l == 0) tab[184] = __expf(a) - __expf(c) + 0.2f; }
        __syncthreads();
        const int q0 = PADF + NMETA + qb * 256;
        const bf16_t* Pb = p.P() + (size_t)b * LP * NPROJ;
        const size_t ooff = (size_t)(b * SEQ + qb * 256) * 1024 + h * 256 + dvh * 128;
#pragma unroll 1
        for (int pass = 0; pass < 2; ++pass)
            att::attn_pass(pass, Pb + (size_t)q0 * NPROJ + h * 256 + pass * 128, Pb + 1024 + h * 256 + pass * 128, Pb + 2048 + h * 256 + dvh * 128, (pass ? p.HS() : p.OS()) + ooff, q0, lds);
    }
}
__device__ __forceinline__ void phase_yda(const Params& p) {
    const int tid = otid(), wid = tid >> 6, lane = tid & 63;
    const float4 g = *(const float4*)(p.subln + lane * 4);
    static_assert((NTOK * 4) % (NWG * 8 * 4) == 0, "yda batches");
    for (int w0 = blockIdx.x * 8 + wid; w0 < NTOK * 4; w0 += gridDim.x * 8 * 4) {
        float4 v[4];
#pragma unroll
        for (int q = 0; q < 4; ++q) { const size_t o_ = (size_t)(w0 + q * gridDim.x * 8) * 256 + lane * 4; const float4 a = *(const float4*)(p.OS() + o_), c = *(const float4*)(p.HS() + o_); v[q] = make_float4(a.x - c.x, a.y - c.y, a.z - c.z, a.w - c.w); }
#pragma unroll
        for (int q = 0; q < 4; ++q) { const int w = w0 + q * gridDim.x * 8;
            const float ss = wave_sum(v[q].x * v[q].x + v[q].y * v[q].y + v[q].z * v[q].z + v[q].w * v[q].w); const float rs = rsqrtf(ss / 256.f + EPS) * 0.8f;
            u32x2 o; o.x = cvt_pk_bf16(v[q].x * rs * g.x, v[q].y * rs * g.y); o.y = cvt_pk_bf16(v[q].z * rs * g.z, v[q].w * rs * g.w);
            *(u32x2*)(p.YDM() + (size_t)w * 256 + lane * 4) = o; }
    }
}


namespace mls {
using att::f32x16; using att::s16x4; using att::crow; using att::v_st; using att::v_rd_base; using att::v_rd_off; using att::tr_read; using att::pv_d0;
constexpr int NCH = 33;
__device__ __forceinline__ bf16x8 scale8(bf16x8 v, float w) { const u32x4 u = *reinterpret_cast<u32x4*>(&v); u32x4 o;
    o.x = cvt_pk_bf16(bflo(u.x) * w, bfhi(u.x) * w); o.y = cvt_pk_bf16(bflo(u.y) * w, bfhi(u.y) * w); o.z = cvt_pk_bf16(bflo(u.z) * w, bfhi(u.z) * w); o.w = cvt_pk_bf16(bflo(u.w) * w, bfhi(u.w) * w);
    return *reinterpret_cast<bf16x8*>(&o); }
template <int NCT, bool SCALE>
__device__ __forceinline__ void stage_img(const bf16_t* src, const int ld, char* img, const float* wrow, const int tid) {
    const int sr = tid >> 4, sc = (tid & 15) * 8, o0 = v_st(sr, sc), o1 = v_st(32 + sr, sc);
#pragma unroll
    for (int ct = 0; ct < NCT; ++ct)
#pragma unroll
        for (int rt = 0; rt < 2; ++rt) { const bf16_t* s0 = src + (size_t)(rt * 64 + sr) * ld + ct * 128 + sc;
            bf16x8 v0 = *reinterpret_cast<const bf16x8*>(s0), v1 = *reinterpret_cast<const bf16x8*>(s0 + (size_t)32 * ld);
            if (SCALE) { v0 = scale8(v0, wrow[rt * 64 + sr]); v1 = scale8(v1, wrow[rt * 64 + 32 + sr]); }
            *reinterpret_cast<bf16x8*>(img + (ct * 2 + rt) * 16384 + o0) = v0; *reinterpret_cast<bf16x8*>(img + (ct * 2 + rt) * 16384 + o1) = v1; }
}
__device__ __forceinline__ void m0_conv_gates(const Params& p) {
    const int tid = otid(), wid = tid >> 6, lane = tid & 63;
    const bf16_t* P = p.P(); bf16_t* Qc = p.Qc(); bf16_t* Kc = p.Kc();
    {
        const int c8 = (tid & 127) * 8; const float sc = c8 < 512 ? 0.08838834764831845f : 1.0f;
        float4 w0[5], w1[5];
#pragma unroll
        for (int j = 0; j < 5; ++j) { w0[j] = *(const float4*)(p.conv_w + j * 1024 + c8); w1[j] = *(const float4*)(p.conv_w + j * 1024 + c8 + 4); }
        const int stride = gridDim.x * 512;
        for (int idx0 = blockIdx.x * 512 + tid; idx0 < R * 128; idx0 += 2 * stride) {
            u32x4 u[2][5];
#pragma unroll
            for (int q = 0; q < 2; ++q) { const int idx = idx0 + q * stride, r = idx >> 7, pp = r % LP;
#pragma unroll
                for (int j = 0; j < 5; ++j) { const int rr = r + j - 2, pin = pp + j - 2; u[q][j] = (u32x4){0u, 0u, 0u, 0u};
                    if (idx < R * 128 && pp >= PADF && pin >= PADF && pin < LP) u[q][j] = *(const u32x4*)(P + (size_t)rr * NPROJ + C_MQ + c8); } }
#pragma unroll
            for (int q = 0; q < 2; ++q) { const int idx = idx0 + q * stride, r = idx >> 7; if (idx >= R * 128) break;
                float acc[8];
#pragma unroll
                for (int j = 0; j < 8; ++j) acc[j] = 0.f;
#pragma unroll
                for (int j = 0; j < 5; ++j) { const u32x4 t = u[q][j];
                    acc[0] += w0[j].x * bflo(t.x); acc[1] += w0[j].y * bfhi(t.x); acc[2] += w0[j].z * bflo(t.y); acc[3] += w0[j].w * bfhi(t.y);
                    acc[4] += w1[j].x * bflo(t.z); acc[5] += w1[j].y * bfhi(t.z); acc[6] += w1[j].z * bflo(t.w); acc[7] += w1[j].w * bfhi(t.w); }
#pragma unroll
                for (int j = 0; j < 8; ++j) acc[j] = acc[j] * __builtin_amdgcn_rcpf(1.0f + __expf(-acc[j])) * sc;
                u32x4 o; o.x = cvt_pk_bf16(acc[0], acc[1]); o.y = cvt_pk_bf16(acc[2], acc[3]); o.z = cvt_pk_bf16(acc[4], acc[5]); o.w = cvt_pk_bf16(acc[6], acc[7]);
                if (c8 < 512) *(u32x4*)(Qc + (size_t)r * 512 + c8) = o; else *(u32x4*)(Kc + (size_t)r * 512 + (c8 - 512)) = o; }
        }
    }
    for (int task = blockIdx.x * 8 + wid; task < 16 * NCH; task += gridDim.x * 8) {
        const int seq = task / NCH, c = task % NCH, b = seq >> 3, h = (seq >> 1) & 3, dir = seq & 1;
        const float bi = p.gate_bias[(dir * 2) * 4 + h], bfb = p.gate_bias[(dir * 2 + 1) * 4 + h];
        float li[2], lf[2]; int tt[2];
#pragma unroll
        for (int q = 0; q < 2; ++q) { const int i = 2 * lane + q, t = dir ? 127 - i : i, pp = c * 128 + t; tt[q] = t;
            if (pp >= PADF) { const float* g = p.gates() + (size_t)(b * LP + pp) * 16; li[q] = g[(dir * 2) * 4 + h] + bi; lf[q] = logsigmoidf_(g[(dir * 2 + 1) * 4 + h] + bfb); }
            else { li[q] = -__builtin_inff(); lf[q] = 0.f; } }
        float s1 = lf[0] + lf[1], incl = s1;
#pragma unroll
        for (int o = 1; o < 64; o <<= 1) { const float t = __shfl_up(incl, o); if (lane >= o) incl += t; }
        const float b1 = incl, b0 = incl - lf[1];
        const float a0 = li[0] - b0, a1 = li[1] - b1;
        float pm = fmaxf(a0, a1), run = pm;
#pragma unroll
        for (int o = 1; o < 64; o <<= 1) { const float t = __shfl_up(run, o); if (lane >= o) run = fmaxf(run, t); }
        const float excl = __shfl_up(run, 1); const float pm0 = lane ? fmaxf(excl, a0) : a0, pm1 = run;
        float* GB = p.GB() + (size_t)seq * LP + c * 128; float* GA = p.GA() + (size_t)seq * LP + c * 128; float* GPM = p.GPM() + (size_t)seq * LP + c * 128;
        GB[tt[0]] = b0; GB[tt[1]] = b1; GA[tt[0]] = a0; GA[tt[1]] = a1; GPM[tt[0]] = pm0; GPM[tt[1]] = pm1;
        const float Atot = __shfl(run, 63), Btot = __shfl(incl, 63);
        if (lane == 0) { p.CS()[(seq * NCH + c) * 2] = Atot; p.CS()[(seq * NCH + c) * 2 + 1] = Btot; }
    }
}
__device__ __forceinline__ void m1_summaries(const Params& p, unsigned char* lds_) {
    char* lds = (char*)lds_; char* Vimg = lds; char* Kimg = lds + 65536; float* wrow = (float*)(lds + 98304);
    for (int it = blockIdx.x; it < 512; it += gridDim.x) {
        int tid_ = threadIdx.x; asm volatile("" : "+v"(tid_)); const int tid = tid_, wid = tid >> 6, lane = tid & 63, r32 = lane & 31, hi = lane >> 5;
        const int seq = it >> 5, k = it & 31, b = seq >> 3, h = (seq >> 1) & 3, dir = seq & 1, c = dir ? 32 - k : k;
        const int r0 = b * LP + c * 128;
        if (tid < 128) wrow[tid] = __expf(p.GA()[(size_t)seq * LP + c * 128 + tid] - p.CS()[(seq * NCH + c) * 2]);
        __syncthreads();
        stage_img<1, false>(p.Kc() + (size_t)r0 * 512 + h * 128, 512, Kimg, nullptr, tid);
        stage_img<2, true>(p.P() + (size_t)r0 * NPROJ + C_MV + h * 256, NPROJ, Vimg, wrow, tid);
        if (tid < 128) { float s = 0.f; const bf16_t* kp = p.Kc() + (size_t)r0 * 512 + h * 128 + tid; for (int q = 0; q < 128; ++q) s += wrow[q] * bf2f(kp[(size_t)q * 512]); p.DN()[((size_t)seq * NCH + c) * 128 + tid] = s; }
        __syncthreads();
        const int dkb = wid & 3, dvh = wid >> 2;
        f32x16 o[4] = {};
        const int vbV = (int)(uintptr_t)Vimg + v_rd_base(lane) + dvh * 32768, vbK = (int)(uintptr_t)Kimg + v_rd_base(lane) + dkb * 512;
#pragma unroll
        for (int rt = 0; rt < 2; ++rt) {
            const int kb = vbK + rt * 16384;
            const s16x4 l0 = tr_read<v_rd_off(0, 0, 0)>(kb), h0 = tr_read<v_rd_off(0, 0, 1)>(kb), l1 = tr_read<v_rd_off(0, 1, 0)>(kb), h1 = tr_read<v_rd_off(0, 1, 1)>(kb);
            const s16x4 l2 = tr_read<v_rd_off(0, 2, 0)>(kb), h2 = tr_read<v_rd_off(0, 2, 1)>(kb), l3 = tr_read<v_rd_off(0, 3, 0)>(kb), h3 = tr_read<v_rd_off(0, 3, 1)>(kb);
            asm volatile("s_waitcnt lgkmcnt(0)" ::: "memory"); __builtin_amdgcn_sched_barrier(0);
#define PK(L, H) (bf16x8){L[0], L[1], L[2], L[3], H[0], H[1], H[2], H[3]}
            pv_d0(o, vbV + rt * 16384, PK(l0, h0), PK(l1, h1), PK(l2, h2), PK(l3, h3));
#undef PK
        }
        float* dc = p.DC() + ((size_t)seq * NCH + c) * 32768;
#pragma unroll
        for (int r = 0; r < 16; ++r) { const int dk = dkb * 32 + crow(r, hi);
#pragma unroll
            for (int d0 = 0; d0 < 4; ++d0) dc[(size_t)dk * 256 + dvh * 128 + d0 * 32 + r32] = o[d0][r]; }
        __syncthreads();
    }
}
__device__ __forceinline__ void m2_scan(const Params& p) {
    const int gid = blockIdx.x * 512 + otid();
    for (int g = gid; g < 16 * 128 * 64; g += gridDim.x * 512) {
        const int seq = g >> 13, rem = g & 8191, dk = rem >> 6, dv4 = (rem & 63) * 4, dir = seq & 1;
        float4 C = make_float4(0.f, 0.f, 0.f, 0.f); float n = 0.f, m = 0.f;
        for (int k0 = 0; k0 < NCH; k0 += 8) {
            float4 d[8]; float dn[8];
#pragma unroll
            for (int j = 0; j < 8; ++j) { const int k = k0 + j; if (k < NCH - 1) { const int c = dir ? 32 - k : k; const size_t sc = (size_t)seq * NCH + c;
                d[j] = *(const float4*)(p.DC() + sc * 32768 + (size_t)dk * 256 + dv4); dn[j] = dv4 == 0 ? p.DN()[sc * 128 + dk] : 0.f; } else { d[j] = make_float4(0.f, 0.f, 0.f, 0.f); dn[j] = 0.f; } }
#pragma unroll
            for (int j = 0; j < 8; ++j) { const int k = k0 + j; if (k < NCH) { const int c = dir ? 32 - k : k; const size_t sc = (size_t)seq * NCH + c;
                u32x2 w; w.x = cvt_pk_bf16(C.x, C.y); w.y = cvt_pk_bf16(C.z, C.w); *(u32x2*)(p.Cst() + sc * 32768 + (size_t)dk * 256 + dv4) = w;
                if (dv4 == 0) p.Nst()[sc * 128 + dk] = n; if (rem == 0) p.Mst()[sc] = m;
                if (k < NCH - 1) { const float A = p.CS()[sc * 2], B = p.CS()[sc * 2 + 1], Mx = fmaxf(m, A), wc = __expf(m - Mx), ws = __expf(A - Mx);
                    C.x = wc * C.x + ws * d[j].x; C.y = wc * C.y + ws * d[j].y; C.z = wc * C.z + ws * d[j].z; C.w = wc * C.w + ws * d[j].w;
                    n = wc * n + ws * dn[j]; m = B + Mx; } } }
        }
    }
}
#define KSWZ(row, colB) ((row) * 256 + ((colB) ^ (((row) & 7) << 4)))
__device__ __forceinline__ void m3_outputs(const Params& p, unsigned char* lds_) {
    char* lds = (char*)lds_; char* Vimg = lds; char* Cimg = lds + 65536; char* Kt = lds + 65536;
    float* tabA = (float*)(lds + 131072);
    float* tabN = tabA + 256;
    float* wsc = tabN + 128;
    for (int it = blockIdx.x; it < 256; it += gridDim.x) {
        int tid_ = threadIdx.x; asm volatile("" : "+v"(tid_)); const int tid = tid_, wid = tid >> 6, lane = tid & 63, r32 = lane & 31, hi = lane >> 5;
        float* ws = wsc + wid * 64;
        const int c = 1 + (it & 31), bh = it >> 5, b = bh >> 2, h = bh & 3, r0 = b * LP + c * 128, tt = wid & 3, dvh = wid >> 2, t = tt * 32 + r32;
        { const int sr = tid >> 4, sc = (tid & 15) * 8;
#pragma unroll
          for (int rt = 0; rt < 2; ++rt) { const bf16_t* s0 = p.Kc() + (size_t)(r0 + rt * 64 + sr) * 512 + h * 128 + sc;
              *reinterpret_cast<bf16x8*>(Kt + rt * 16384 + KSWZ(sr, sc * 2)) = *reinterpret_cast<const bf16x8*>(s0);
              *reinterpret_cast<bf16x8*>(Kt + rt * 16384 + KSWZ(32 + sr, sc * 2)) = *reinterpret_cast<const bf16x8*>(s0 + 32 * 512); } }
        stage_img<2, false>(p.P() + (size_t)r0 * NPROJ + C_MV + h * 256, NPROJ, Vimg, nullptr, tid);
        if (tid < 256) { const int dir = tid >> 7, s = tid & 127; tabA[tid] = p.GA()[(size_t)((b * 4 + h) * 2 + dir) * LP + c * 128 + s]; }
        bf16x8 qr[8];
        { const bf16_t* Qw = p.Qc() + (size_t)(r0 + t) * 512 + h * 128 + hi * 8;
#pragma unroll
          for (int d0 = 0; d0 < 8; ++d0) qr[d0] = *reinterpret_cast<const bf16x8*>(Qw + d0 * 16); }
        __syncthreads();
        f32x16 s0a, s0b, s1a, s1b;
        att::qkt(s0a, s0b, (const bf16_t*)Kt, qr, r32, hi); att::qkt(s1a, s1b, (const bf16_t*)(Kt + 16384), qr, r32, hi);
        __syncthreads();
#pragma unroll 1
        for (int dir = 0; dir < 2; ++dir) {
            const int seq = (b * 4 + h) * 2 + dir; const size_t sc = (size_t)seq * NCH + c;
            stage_img<2, false>(p.Cst() + sc * 32768, 256, Cimg, nullptr, tid);
            if (tid < 128) tabN[tid] = p.Nst()[sc * 128 + tid];
            const float mc = p.Mst()[sc], pmt = p.GPM()[(size_t)seq * LP + c * 128 + t], bt = p.GB()[(size_t)seq * LP + c * 128 + t];
            const float Mt = fmaxf(mc, pmt), winter = __expf(mc - Mt), einv = __expf(-(bt + Mt));
            __syncthreads();
            int t_o = t, hi_o = hi; asm volatile("" : "+v"(t_o), "+v"(hi_o));
            const float* ta = tabA + dir * 128 + 4 * hi_o; const int tq = t_o - 4 * hi_o;
            float qn = 0.f;
#pragma unroll
            for (int d0 = 0; d0 < 8; ++d0) { const u32x4 u = *reinterpret_cast<const u32x4*>(&qr[d0]); const float* nn = tabN + d0 * 16 + hi * 8;
                qn += bflo(u.x) * nn[0] + bfhi(u.x) * nn[1] + bflo(u.y) * nn[2] + bfhi(u.y) * nn[3] + bflo(u.z) * nn[4] + bfhi(u.z) * nn[5] + bflo(u.w) * nn[6] + bfhi(u.w) * nn[7]; }
            { auto rr = __builtin_amdgcn_permlane32_swap(__float_as_uint(qn), __float_as_uint(qn), false, false); qn = __uint_as_float(rr[0]) + __uint_as_float(rr[1]); }
            if (hi == 0) ws[r32] = winter;
            f32x16 o[4] = {};
            const int vbC = (int)(uintptr_t)Cimg + v_rd_base(lane) + dvh * 32768, vbV = (int)(uintptr_t)Vimg + v_rd_base(lane) + dvh * 32768;
            pv_d0(o, vbC, qr[0], qr[1], qr[2], qr[3]); pv_d0(o, vbC + 16384, qr[4], qr[5], qr[6], qr[7]);
            asm volatile("s_waitcnt lgkmcnt(0)" ::: "memory");
#pragma unroll
            for (int r = 0; r < 16; ++r) { const float wi = ws[crow(r, hi)];
#pragma unroll
                for (int d0 = 0; d0 < 4; ++d0) o[d0][r] *= wi; }
            __builtin_amdgcn_sched_barrier(0);
            float rs = 0.f; bf16x8 sa0, sa1, sa2, sa3;
#define WGT(SV, KB, OUT0, OUT1) do { float e[16]; _Pragma("unroll") for (int r = 0; r < 16; ++r) { const int s4 = (KB) + (r & 3) + 8 * (r >> 2); const int d = dir ? s4 - tq : tq - s4; \
                const float w = __expf(ta[s4] - Mt + (float)min(d, 0) * 1e30f); e[r] = SV[r] * w; rs += e[r]; } \
                { unsigned a0 = cvt_pk_bf16(e[0], e[1]), a1 = cvt_pk_bf16(e[2], e[3]), b0 = cvt_pk_bf16(e[4], e[5]), b1 = cvt_pk_bf16(e[6], e[7]); \
                  auto x0 = __builtin_amdgcn_permlane32_swap(a0, b0, false, false); auto x1 = __builtin_amdgcn_permlane32_swap(a1, b1, false, false); u32x4 w4 = {x0[0], x1[0], x0[1], x1[1]}; OUT0 = *reinterpret_cast<bf16x8*>(&w4); } \
                { unsigned a0 = cvt_pk_bf16(e[8], e[9]), a1 = cvt_pk_bf16(e[10], e[11]), b0 = cvt_pk_bf16(e[12], e[13]), b1 = cvt_pk_bf16(e[14], e[15]); \
                  auto x0 = __builtin_amdgcn_permlane32_swap(a0, b0, false, false); auto x1 = __builtin_amdgcn_permlane32_swap(a1, b1, false, false); u32x4 w4 = {x0[0], x1[0], x0[1], x1[1]}; OUT1 = *reinterpret_cast<bf16x8*>(&w4); } } while (0)
            WGT(s0a, 0, sa0, sa1); __builtin_amdgcn_sched_barrier(0); WGT(s0b, 32, sa2, sa3); __builtin_amdgcn_sched_barrier(0);
            pv_d0(o, vbV, sa0, sa1, sa2, sa3); __builtin_amdgcn_sched_barrier(0);
            WGT(s1a, 64, sa0, sa1); __builtin_amdgcn_sched_barrier(0); WGT(s1b, 96, sa2, sa3); __builtin_amdgcn_sched_barrier(0);
            pv_d0(o, vbV + 16384, sa0, sa1, sa2, sa3);
#undef WGT
            { auto rr = __builtin_amdgcn_permlane32_swap(__float_as_uint(rs), __float_as_uint(rs), false, false); rs = __uint_as_float(rr[0]) + __uint_as_float(rr[1]); }
            const float den = winter * qn + rs; const float hscale = __builtin_amdgcn_rcpf(fmaxf(fabsf(den), einv));
            if (hi == 0) ws[32 + r32] = hscale;
            asm volatile("s_waitcnt lgkmcnt(0)" ::: "memory");
            int r32o = r32, hi_e = hi; asm volatile("" : "+v"(r32o), "+v"(hi_e));
            const unsigned tok0 = (unsigned)(b * SEQ + (c - 1) * 128 + tt * 32), colo = (unsigned)(h * 256 + dvh * 128 + r32o);
            if (dir == 0) {
#pragma unroll
                for (int r = 0; r < 16; ++r) { const float hs_ = ws[32 + crow(r, hi_e)]; float* hp = (float*)((char*)p.HS() + ((tok0 + crow(r, hi_e)) * 1024u + colo) * 4u);
#pragma unroll
                    for (int d0 = 0; d0 < 4; ++d0) hp[d0 * 32] = o[d0][r] * hs_; }
            } else {
                const unsigned prow0 = (unsigned)tok2prow((int)tok0);
#pragma unroll
                for (int r = 0; r < 16; ++r) { const float hs_ = ws[32 + crow(r, hi_e)]; const unsigned tok = tok0 + crow(r, hi_e);
                    const float* hp = (const float*)((const char*)p.HS() + (tok * 1024u + colo) * 4u); const bf16_t* op = (const bf16_t*)((const char*)p.P() + ((prow0 + crow(r, hi_e)) * (unsigned)NPROJ + C_MO + colo) * 2u);
                    bf16_t* yp = (bf16_t*)((char*)p.YDM() + (((unsigned)NTOK + tok) * 1024u + colo) * 2u);
#pragma unroll
                    for (int d0 = 0; d0 < 4; ++d0) { const float hv = hp[d0 * 32] + o[d0][r] * hs_; const float g = __builtin_amdgcn_rcpf(1.0f + __expf(-bf2f(op[d0 * 32])));
                        yp[d0 * 32] = (bf16_t)(cvt_pk_bf16(g * hv, 0.f) & 0xffffu); }
                    asm volatile("" ::: "memory"); }
            }
            __syncthreads();
        }
    }
}
#undef KSWZ
}

struct SchedBranch { static constexpr bool BTILED = false; static constexpr bool GATHER = false; pg8::TileOrder T;
    __device__ bool next(int i, pg8::Unit& u) const { int pm, pn; if (!T.tile(i >> 1, pm, pn)) return false; const int which = 1 - (i & 1);
        u.a0 = which * NTOK + pm * 256; u.b0 = which * 2048 + pn * 256; u.r0 = pm * 256; u.c0 = pn * 256; u.aux = which; u.nv = 256; u.rot = 0; return true; }
    __device__ int arow(const pg8::Unit&, int) const { return 0; } };
struct EpiBranch { static constexpr bool PERM = true; bf16_t* MIX; const bf16_t* P;
    __device__ __forceinline__ pg8::PF prefetch(const pg8::Unit& u, int tid) const { unsigned v[4];
#pragma unroll
        for (int j = 0; j < 4; ++j) { const int L = j * 512 + tid, row = L >> 3, seg = L & 7; v[j] = *(const __attribute__((address_space(1))) unsigned char*)((const __attribute__((address_space(1))) char*)P + ((size_t)tok2prow(u.r0 + row) * NPROJ + 6144 + u.c0 + (seg >> 2) * 2048) * 2 + (seg & 3) * 128); }
        return pg8::PF{v[0], v[1], v[2], v[3]}; }
    __device__ __forceinline__ bool keep(const pg8::Unit& u) const { return u.aux == 1; }
    __device__ __forceinline__ void operator()(f32x4 (&acc)[2][2][4][2], const pg8::Unit& u, int wr, int wc, int fr, int fq) const {
        const int col0 = u.c0 + wc * 32 + 8 * fq; const int which = u.aux;
#pragma unroll
        for (int ai = 0; ai < 2; ++ai)
#pragma unroll
            for (int m2 = 0; m2 < 4; m2 += 2) { u32x4 g0r[2][2], g1r[2][2];
#pragma unroll
                for (int q = 0; q < 2; ++q) { const int tok = u.r0 + ai * 128 + wr * 64 + (m2 + q) * 16 + fr; const bf16_t* gp = P + (size_t)tok2prow(tok) * NPROJ + 6144 + col0;
#pragma unroll
                    for (int bj = 0; bj < 2; ++bj) { g0r[q][bj] = *(const u32x4*)(gp + bj * 128); if (which == 1) g1r[q][bj] = *(const u32x4*)(gp + 2048 + bj * 128); } }
#pragma unroll
                for (int q = 0; q < 2; ++q) { const int m = m2 + q; const int tok = u.r0 + ai * 128 + wr * 64 + m * 16 + fr;
#pragma unroll
                    for (int bj = 0; bj < 2; ++bj) { const u32x4 g0 = g0r[q][bj];
                        f32x4 v0 = acc[ai][bj][m][0], v1 = acc[ai][bj][m][1];
                        if (which == 1) { const u32x4 g1 = g1r[q][bj];
                            v0[0] *= bflo(g1.x) * __builtin_amdgcn_rcpf(bflo(g0.x)); v0[1] *= bfhi(g1.x) * __builtin_amdgcn_rcpf(bfhi(g0.x)); v0[2] *= bflo(g1.y) * __builtin_amdgcn_rcpf(bflo(g0.y)); v0[3] *= bfhi(g1.y) * __builtin_amdgcn_rcpf(bfhi(g0.y));
                            v1[0] *= bflo(g1.z) * __builtin_amdgcn_rcpf(bflo(g0.z)); v1[1] *= bfhi(g1.z) * __builtin_amdgcn_rcpf(bfhi(g0.z)); v1[2] *= bflo(g1.w) * __builtin_amdgcn_rcpf(bflo(g0.w)); v1[3] *= bfhi(g1.w) * __builtin_amdgcn_rcpf(bfhi(g0.w));
                            acc[ai][bj][m][0] = v0; acc[ai][bj][m][1] = v1;
                        } else {
                            v0[0] *= bflo(g0.x); v0[1] *= bfhi(g0.x); v0[2] *= bflo(g0.y); v0[3] *= bfhi(g0.y); v1[0] *= bflo(g0.z); v1[1] *= bfhi(g0.z); v1[2] *= bflo(g0.w); v1[3] *= bfhi(g0.w);
                            u32x4 w; w.x = cvt_pk_bf16(v0[0], v0[1]); w.y = cvt_pk_bf16(v0[2], v0[3]); w.z = cvt_pk_bf16(v1[0], v1[1]); w.w = cvt_pk_bf16(v1[2], v1[3]);
                            *(u32x4*)(MIX + (size_t)tok * D + col0 + bj * 128) = w; } } } }
    }
};
struct SchedOut { static constexpr bool BTILED = false; static constexpr bool GATHER = false; pg8::TileOrder T;
    __device__ bool next(int i, pg8::Unit& u) const { int pm, pn; if (!T.tile(i, pm, pn)) return false; u.a0 = pm * 256; u.b0 = pn * 256; u.r0 = pm * 256; u.c0 = pn * 256; u.aux = 0; u.nv = 256; u.rot = 0; return true; }
    __device__ int arow(const pg8::Unit&, int) const { return 0; } };
struct EpiOut { __device__ __forceinline__ bool keep(const pg8::Unit&) const { return false; } static constexpr bool PERM = true; const float* x; bf16_t* H1;
    __device__ __forceinline__ pg8::PF prefetch(const pg8::Unit& u, int tid) const { unsigned v[4];
#pragma unroll
        for (int j = 0; j < 4; ++j) { const int L = j * 512 + tid, row = L >> 3, seg = L & 7; v[j] = *(const __attribute__((address_space(1))) unsigned char*)((const __attribute__((address_space(1))) char*)x + ((size_t)(u.r0 + row) * D + u.c0) * 4 + seg * 128); }
        return pg8::PF{v[0], v[1], v[2], v[3]}; }
    __device__ __forceinline__ void operator()(f32x4 (&acc)[2][2][4][2], const pg8::Unit& u, int wr, int wc, int fr, int fq) const {
        const int row0 = u.r0 + wr * 64 + fr, col0 = u.c0 + wc * 32 + 8 * fq;
#pragma unroll
        for (int ai = 0; ai < 2; ++ai)
#pragma unroll
            for (int m2 = 0; m2 < 4; m2 += 2) { f32x4 xr[2][2][2];
#pragma unroll
                for (int q = 0; q < 2; ++q) { const size_t o = (size_t)(row0 + ai * 128 + (m2 + q) * 16) * D + col0;
#pragma unroll
                    for (int bj = 0; bj < 2; ++bj) { xr[q][bj][0] = *(const f32x4*)(x + o + bj * 128); xr[q][bj][1] = *(const f32x4*)(x + o + bj * 128 + 4); } }
#pragma unroll
                for (int q = 0; q < 2; ++q) { const int m = m2 + q; const size_t o = (size_t)(row0 + ai * 128 + m * 16) * D + col0;
#pragma unroll
                    for (int bj = 0; bj < 2; ++bj) { const f32x4 v0 = xr[q][bj][0] + acc[ai][bj][m][0], v1 = xr[q][bj][1] + acc[ai][bj][m][1];
                        u32x4 w; w.x = cvt_pk_bf16(v0[0], v0[1]); w.y = cvt_pk_bf16(v0[2], v0[3]); w.z = cvt_pk_bf16(v1[0], v1[1]); w.w = cvt_pk_bf16(v1[2], v1[3]);
                        *(u32x4*)(H1 + o + bj * 128) = w; } } }
    }
};

__device__ __forceinline__ void phase_router(const Params& p, unsigned char* lds_) {
    typedef float f32x16 __attribute__((ext_vector_type(16)));
    LAS unsigned char* lds = (LAS unsigned char*)lds_;
    LAS float* LPart = (LAS float*)lds;
    LAS float* SsqP = (LAS float*)(lds + 32768);
    LAS float* Lg = (LAS float*)(lds + 32768 + 2048);
    LAS float* rsv = (LAS float*)(lds + 32768 + 2048 + 4352);
    LAS int* selE = (LAS int*)(lds + 40960);
    LAS int* baseE = selE + 128;
    const int tid = otid(), wid = tid >> 6, lane = tid & 63, i = lane & 31, hi = lane >> 5;
    for (int tb = blockIdx.x; tb < NTOK / 32; tb += gridDim.x) {
        const int tok0 = tb * 32;
        {
            const bf16_t* hrow = p.H1() + (size_t)(tok0 + i) * D + wid * 256 + hi * 128;
            const float* gptr = p.norm_ffn + wid * 256 + hi * 128;
            const float* wr = p.w_router + (size_t)(wid * 256 + hi * 128) * NE + i;
            f32x16 acc = {}; float ssq = 0.f;
#pragma unroll 4
            for (int s4 = 0; s4 < 32; ++s4) { const u32x2 hu = *(const u32x2*)(hrow + s4 * 4); const float4 a = make_float4(bflo(hu.x), bfhi(hu.x), bflo(hu.y), bfhi(hu.y)); const float4 g = *(const float4*)(gptr + s4 * 4);
                ssq += a.x * a.x + a.y * a.y + a.z * a.z + a.w * a.w;
                const float b0 = wr[(s4 * 4 + 0) * NE], b1 = wr[(s4 * 4 + 1) * NE], b2 = wr[(s4 * 4 + 2) * NE], b3 = wr[(s4 * 4 + 3) * NE];
                acc = __builtin_amdgcn_mfma_f32_32x32x2f32(a.x * g.x, b0, acc, 0, 0, 0); acc = __builtin_amdgcn_mfma_f32_32x32x2f32(a.y * g.y, b1, acc, 0, 0, 0);
                acc = __builtin_amdgcn_mfma_f32_32x32x2f32(a.z * g.z, b2, acc, 0, 0, 0); acc = __builtin_amdgcn_mfma_f32_32x32x2f32(a.w * g.w, b3, acc, 0, 0, 0); }
#pragma unroll
            for (int r = 0; r < 16; ++r) { const int row = (r & 3) + 8 * (r >> 2) + 4 * hi; LPart[(wid * 32 + row) * 32 + i] = acc[r]; }
            SsqP[(wid * 2 + hi) * 32 + i] = ssq;
        }
        __syncthreads();
#pragma unroll
        for (int q = 0; q < 2; ++q) { const int idx = tid + 512 * q, tok = idx >> 5, e = idx & 31; float s = 0.f, ss = 0.f;
#pragma unroll
            for (int w = 0; w < 8; ++w) s += LPart[(w * 32 + tok) * 32 + e];
#pragma unroll
            for (int j = 0; j < 16; ++j) ss += SsqP[j * 32 + tok];
            const float rs = rsqrtf(ss / D + EPS); Lg[tok * 33 + e] = rs * s + p.b_router[e]; if (e == 0) rsv[tok] = rs; }
        __syncthreads();
#pragma unroll
        for (int q = 0; q < 4; ++q) { const int tok = wid * 4 + q; float cur = Lg[tok * 33 + i]; float tv[4]; int ti[4];
#pragma unroll
            for (int r = 0; r < 4; ++r) { float bv = cur; int bi = i;
#pragma unroll
                for (int o = 16; o >= 1; o >>= 1) { const float ov = __shfl_xor(bv, o); const int oi = __shfl_xor(bi, o); if (ov > bv || (ov == bv && oi < bi)) { bv = ov; bi = oi; } }
                tv[r] = bv; ti[r] = bi; if (i == bi) cur = -3e38f; }
            float ex[4], sm = 0.f;
#pragma unroll
            for (int r = 0; r < 4; ++r) { ex[r] = __expf(tv[r] - tv[0]); sm += ex[r]; }
            if (lane == 0) {
#pragma unroll
                for (int r = 0; r < 4; ++r) { selE[tok * 4 + r] = ti[r]; p.topW()[(size_t)(tok0 + tok) * 4 + r] = ex[r] / sm; } } }
        __syncthreads();
        if (tid < 32) { int c = 0; for (int j = 0; j < 128; ++j) c += (selE[j] == tid) ? 1 : 0; baseE[tid] = c ? atomicAdd(&p.cursor()[tid], c) : 0; }
        __syncthreads();
        if (tid < 128) { const int e = selE[tid]; int rank = 0; for (int j = 0; j < tid; ++j) rank += (selE[j] == e) ? 1 : 0; const int pos = baseE[e] + rank;
            p.list()[e * ECAP + pos] = tok0 + (tid >> 2); p.dest()[(size_t)(tok0 + (tid >> 2)) * 4 + (tid & 3)] = e * ECAP + pos; }
#pragma unroll
        for (int q = 0; q < 4; ++q) { const int tok = wid * 4 + q; const float rs = rsv[tok]; u32x2 hu[8]; float4 g[8];
#pragma unroll
            for (int c8 = 0; c8 < 8; ++c8) { const int col = c8 * 256 + lane * 4; hu[c8] = *(const u32x2*)(p.H1() + (size_t)(tok0 + tok) * D + col); g[c8] = *(const float4*)(p.norm_ffn + col); }
#pragma unroll
            for (int c8 = 0; c8 < 8; ++c8) { const int col = c8 * 256 + lane * 4; const float4 a = make_float4(bflo(hu[c8].x), bfhi(hu[c8].x), bflo(hu[c8].y), bfhi(hu[c8].y));
                *(unsigned*)((unsigned char*)p.HN() + (size_t)(tok0 + tok) * D + col) = pk4_fp8(a.x * rs * g[c8].x, a.y * rs * g[c8].y, a.z * rs * g[c8].z, a.w * rs * g[c8].w); } }
        __syncthreads();
    }
}
constexpr int MT_OFF = 131072, MT_BIAS = 3584;
__device__ __forceinline__ int rfl(int v) { return __builtin_amdgcn_readfirstlane(v); }
template <int NPN>
__device__ __forceinline__ void moe_tables(const Params& p, unsigned char* lds_) {
    LAS int* tab = (LAS int*)((LAS unsigned char*)lds_ + MT_OFF);
    const int tid = otid(), lane = tid & 63;
    if (tid < 32) { const int e = lane, c = p.cursor()[e], ntl = (c + 255) >> 8; int incl = ntl;
#pragma unroll
        for (int o = 1; o < 32; o <<= 1) { const int t = __shfl_up(incl, o); if (lane >= o) incl += t; }
        const int toff = incl - ntl; tab[e] = c; tab[32 + e] = toff * 256;
        for (int j = 0; j < ntl; ++j) { tab[96 + toff + j] = e; tab[256 + toff + j] = j; }
        if (e == 31) tab[64] = incl; }
    __syncthreads();
    { const int T = tab[64], c = blockIdx.x, xs = c & 7, sx = c >> 3, ngrp = (T + 3) >> 2, nblk = NPN == 16 ? ngrp * 2 : ngrp; bool valid = false;
      if (tid < 16) { const int b = tid * 8 + xs; if (b < nblk) { const int g = NPN == 16 ? (b >> 1) : b, half = NPN == 16 ? (b & 1) : 0, tile = 4 * g + (sx & 3), pn = half * 8 + (sx >> 2);
          if (tile < T) { valid = true; const int e = tab[96 + tile], j = tab[256 + tile], cnt = tab[e], cb = tab[32 + e]; LAS int* u = tab + 448 + tid * 8; const int rem = cnt - j * 256;
              if (NPN == 16) { u[0] = tid * 256; u[1] = e * 4096 + pn * 256; u[2] = cb + j * 256; u[3] = pn * 128; u[4] = e; u[5] = rem < 256 ? rem : 256; u[6] = 0; u[7] = e * ECAP + j * 256; }
              else { u[0] = cb + j * 256; u[1] = e * 2048 + pn * 256; u[2] = cb + j * 256; u[3] = pn * 256; u[4] = e; u[5] = 256; u[6] = 0; u[7] = 0; } } } }
      if (tid < 64) { const unsigned long long m = __ballot(valid); if (tid == 0) tab[65] = __popcll(m); } }
    __syncthreads();
    if (NPN == 16) { const int nun = tab[65];
        for (int idx = tid; idx < nun * 256; idx += 512) { const int i = idx >> 8, row = idx & 255, nv = tab[448 + i * 8 + 5], src = tab[448 + i * 8 + 7]; tab[1024 + idx] = p.list()[src + (row < nv ? row : 0)]; } }
    { const int nun = tab[65]; LAS float* bl = (LAS float*)(tab + MT_BIAS);
        for (int idx = tid; idx < nun * 256; idx += 512) { const int i = idx >> 8, c = idx & 255, e = tab[448 + i * 8 + 4], c0 = tab[448 + i * 8 + 3];
            bl[idx] = NPN == 16 ? p.b1[(size_t)e * 4096 + (c < 128 ? c0 + c : 2048 + c0 + c - 128)] : p.b2[(size_t)e * D + c0 + c]; } }
    __syncthreads();
}
struct SchedMoe1 { static constexpr bool BTILED = true; static constexpr bool GATHER = true; const LAS int* tab;
    __device__ bool next(int i, pg8::Unit& u) const { if (i >= rfl(tab[65])) return false; const LAS int* q = tab + 448 + i * 8;
        u.a0 = rfl(q[0]); u.b0 = rfl(q[1]); u.r0 = rfl(q[2]); u.c0 = rfl(q[3]); u.aux = rfl(q[4]); u.nv = rfl(q[5]); u.rot = rfl(q[6]); u.bo = i * 256; return true; }
    __device__ int arow(const pg8::Unit& u, int row) const { return tab[1024 + u.a0 + row]; } };
struct SchedMoe2 { static constexpr bool BTILED = true; static constexpr bool GATHER = false; const LAS int* tab;
    __device__ bool next(int i, pg8::Unit& u) const { if (i >= rfl(tab[65])) return false; const LAS int* q = tab + 448 + i * 8;
        u.a0 = rfl(q[0]); u.b0 = rfl(q[1]); u.r0 = rfl(q[2]); u.c0 = rfl(q[3]); u.aux = rfl(q[4]); u.nv = rfl(q[5]); u.rot = rfl(q[6]); u.bo = i * 256; return true; }
    __device__ int arow(const pg8::Unit&, int) const { return 0; } };
struct EpiSwiglu { __device__ __forceinline__ pg8::PF prefetch(const pg8::Unit&, int) const { return pg8::PF{0u, 0u, 0u, 0u}; } __device__ __forceinline__ bool keep(const pg8::Unit&) const { return false; } static constexpr bool PERM = true; bf16_t* ACT; const LAS float* bl;
    __device__ __forceinline__ void operator()(f32x4 (&acc)[2][2][4][2], const pg8::Unit& u, int wr, int wc, int fr, int fq) const {
        const int row0 = u.r0 + wr * 64 + fr, col0 = u.c0 + wc * 32 + 8 * fq; const LAS float* bg = bl + u.bo + wc * 32 + 8 * fq;
        f32x4 bgv[2], blv[2];
#pragma unroll
        for (int n = 0; n < 2; ++n) { bgv[n] = *(const LAS f32x4*)(bg + 4 * n); blv[n] = *(const LAS f32x4*)(bg + 128 + 4 * n); }
#pragma unroll
        for (int ai = 0; ai < 2; ++ai)
#pragma unroll
            for (int m = 0; m < 4; ++m) { f32x4 o[2];
#pragma unroll
                for (int n = 0; n < 2; ++n) { const f32x4 g4 = acc[ai][0][m][n] * (1.0f / W8_SCALE) + bgv[n], l4 = acc[ai][1][m][n] * (1.0f / W8_SCALE) + blv[n];
#pragma unroll
                    for (int j = 0; j < 4; ++j) { const float g = fminf(g4[j], 7.0f), l = fminf(fmaxf(l4[j], -7.0f), 7.0f); o[n][j] = g * __builtin_amdgcn_rcpf(1.0f + __expf(-1.702f * g)) * (l + 1.0f); } }
                u32x2 w; w.x = pk4_fp8(o[0][0], o[0][1], o[0][2], o[0][3]); w.y = pk4_fp8(o[1][0], o[1][1], o[1][2], o[1][3]);
                *(u32x2*)((unsigned char*)ACT + (size_t)(row0 + ai * 128 + m * 16) * DFF + col0) = w; }
    }
};
struct EpiY { __device__ __forceinline__ pg8::PF prefetch(const pg8::Unit&, int) const { return pg8::PF{0u, 0u, 0u, 0u}; } __device__ __forceinline__ bool keep(const pg8::Unit&) const { return false; } static constexpr bool PERM = true; bf16_t* Y; const LAS float* bl;
    __device__ __forceinline__ void operator()(f32x4 (&acc)[2][2][4][2], const pg8::Unit& u, int wr, int wc, int fr, int fq) const {
        const int row0 = u.r0 + wr * 64 + fr, col0 = u.c0 + wc * 32 + 8 * fq; const LAS float* bb = bl + u.bo + wc * 32 + 8 * fq;
        f32x4 bv[2][2];
#pragma unroll
        for (int bj = 0; bj < 2; ++bj)
#pragma unroll
            for (int n = 0; n < 2; ++n) bv[bj][n] = *(const LAS f32x4*)(bb + bj * 128 + 4 * n);
#pragma unroll
        for (int ai = 0; ai < 2; ++ai)
#pragma unroll
            for (int m = 0; m < 4; ++m) { bf16_t* rowp = Y + (size_t)(row0 + ai * 128 + m * 16) * D + col0;
#pragma unroll
                for (int bj = 0; bj < 2; ++bj) { const f32x4 v0 = acc[ai][bj][m][0] * (1.0f / W8_SCALE) + bv[bj][0], v1 = acc[ai][bj][m][1] * (1.0f / W8_SCALE) + bv[bj][1];
                    u32x4 w; w.x = cvt_pk_bf16(v0[0], v0[1]); w.y = cvt_pk_bf16(v0[2], v0[3]); w.z = cvt_pk_bf16(v1[0], v1[1]); w.w = cvt_pk_bf16(v1[2], v1[3]);
                    *(u32x4*)(rowp + bj * 128) = w; } }
    }
};
__device__ __forceinline__ void phase_final(const Params& p) {
    const int tid = otid(), wid = tid >> 6, lane = tid & 63;
    int cb = 0; { const int c = lane < NE ? p.cursor()[lane] : 0; int pad = ((c + 255) >> 8) << 8; int incl = pad;
#pragma unroll
        for (int o = 1; o < 32; o <<= 1) { const int t = __shfl_up(incl, o); if ((lane & 31) >= o) incl += t; }
        cb = incl - pad; }
    static_assert(NTOK == NWG * 8 * 4, "final: four tokens per wave");
    int4 dA[4]; float4 wA[4];
#pragma unroll
    for (int q = 0; q < 4; ++q) { const int tk = blockIdx.x * 8 + wid + q * NWG * 8; dA[q] = *(const int4*)(p.dest() + (size_t)tk * 4); wA[q] = *(const float4*)(p.topW() + (size_t)tk * 4); }
    u32x2 hb[8], yb[4][8]; float4 g[8];
#pragma unroll
    for (int c8 = 0; c8 < 8; ++c8) g[c8] = *(const float4*)(p.norm_final + c8 * 256 + lane * 4);
#define FIN_LOAD(q_) do { const int tk_ = blockIdx.x * 8 + wid + (q_) * NWG * 8; const int dd_[4] = {dA[q_].x, dA[q_].y, dA[q_].z, dA[q_].w}; \
        _Pragma("unroll") for (int c8 = 0; c8 < 8; ++c8) hb[c8] = *(const u32x2*)(p.H1() + (size_t)tk_ * D + c8 * 256 + lane * 4); \
        _Pragma("unroll") for (int k = 0; k < 4; ++k) { const size_t yr_ = (size_t)(__shfl(cb, dd_[k] >> 13) + (dd_[k] & (ECAP - 1))) * D; \
            _Pragma("unroll") for (int c8 = 0; c8 < 8; ++c8) yb[k][c8] = *(const u32x2*)(p.Y() + yr_ + c8 * 256 + lane * 4); } } while (0)
    FIN_LOAD(0);
#pragma unroll
    for (int q = 0; q < 4; ++q) { const int tk = blockIdx.x * 8 + wid + q * NWG * 8;
        const float w[4] = {wA[q].x, wA[q].y, wA[q].z, wA[q].w};
        float4 v[8]; float ss = 0.f;
#pragma unroll
        for (int c8 = 0; c8 < 8; ++c8) { float4 a = make_float4(bflo(hb[c8].x), bfhi(hb[c8].x), bflo(hb[c8].y), bfhi(hb[c8].y));
#pragma unroll
            for (int k = 0; k < 4; ++k) { const u32x2 y = yb[k][c8]; a.x += w[k] * bflo(y.x); a.y += w[k] * bfhi(y.x); a.z += w[k] * bflo(y.y); a.w += w[k] * bfhi(y.y); }
            v[c8] = a; ss += a.x * a.x + a.y * a.y + a.z * a.z + a.w * a.w; }
        if (q < 3) FIN_LOAD(q + 1);
        ss = wave_sum(ss); const float rs = rsqrtf(ss / D + EPS);
#pragma unroll
        for (int c8 = 0; c8 < 8; ++c8) { const int col = c8 * 256 + lane * 4;
            *(float4*)(p.out + (size_t)tk * D + col) = make_float4(v[c8].x * rs * g[c8].x, v[c8].y * rs * g[c8].y, v[c8].z * rs * g[c8].z, v[c8].w * rs * g[c8].w); }
    }
#undef FIN_LOAD
}

#define XB_TMO      128
#define XB_XCNT(j)  (256  + 64 * (j))
#define XB_XSUB(j)  (1280 + 64 * (j))
#define XB_XGEN(j)  (2304 + 64 * (j))
#define XB_TOP      3328
#define XB_TOPGEN   3392
#define XCD_BAR_WORDS 3456
#define XB_SPIN_CAP (1u << 18)

__device__ __forceinline__ unsigned xb_ld(unsigned* p)              { return __hip_atomic_load(p, __ATOMIC_RELAXED, __HIP_MEMORY_SCOPE_AGENT); }
__device__ __forceinline__ unsigned xb_add(unsigned* p, unsigned v) { return __hip_atomic_fetch_add(p, v, __ATOMIC_RELAXED, __HIP_MEMORY_SCOPE_AGENT); }
__device__ __forceinline__ unsigned xb_xcc_id() { return (unsigned)__builtin_amdgcn_s_getreg((3 << 11) | 20) & 0xFu; }
#define XB_SPIN(cond, bar) do { unsigned _sp = 0; while (cond) { __builtin_amdgcn_s_sleep(1); \
    if ((++_sp & 255u) == 0u) { if (xb_ld(&(bar)[XB_TMO])) break; if (_sp > XB_SPIN_CAP) { atomicAdd(&(bar)[XB_TMO], 1u); break; } } } } while (0)

struct XcdBarrier {
    unsigned* bar; unsigned x;
    volatile LAS unsigned* st;
};

__device__ __forceinline__ XcdBarrier xcd_barrier_post(unsigned* bar, volatile LAS unsigned* st) {
    XcdBarrier b; b.bar = bar; b.x = xb_xcc_id(); b.st = st;
    if (threadIdx.x == 0) (void)xb_add(&bar[XB_XCNT(b.x)], 1u);
    return b;
}
__device__ __forceinline__ void xcd_barrier_complete(unsigned* bar, unsigned x, unsigned& nloc, unsigned& nx) {
    const unsigned G = gridDim.x * gridDim.y * gridDim.z;
    unsigned sum, cnt, mine, sp = 0u;
    for (;;) {
        sum = 0u; cnt = 0u; mine = 0u;
#pragma unroll
        for (unsigned j = 0; j < 16; ++j) { const unsigned c = xb_ld(&bar[XB_XCNT(j)]); sum += c; cnt += (c > 0u) ? 1u : 0u; mine = (j == x) ? c : mine; }
        if (sum == G) break;
        __builtin_amdgcn_s_sleep(1);
        if ((++sp & 255u) == 0u) { if (xb_ld(&bar[XB_TMO])) break; if (sp > XB_SPIN_CAP) { atomicAdd(&bar[XB_TMO], 1u); break; } }
    }
    nloc = mine > 0u ? mine : 1u; nx = cnt > 0u ? cnt : 1u;
}

__device__ __forceinline__ void xcd_barrier(const XcdBarrier& b) {
    asm volatile("s_waitcnt vmcnt(0)" ::: "memory");
    __syncthreads();
    if (threadIdx.x == 0) {
        unsigned* bar = b.bar;
        __builtin_amdgcn_s_waitcnt(0);
        unsigned nloc = b.st[0], nx = b.st[1];
        if (nloc == 0u) { xcd_barrier_complete(bar, b.x, nloc, nx); b.st[0] = nloc; b.st[1] = nx; }
        const unsigned old = xb_add(&bar[XB_XSUB(b.x)], 1u);
        const unsigned gen = old / nloc;
        if (old + 1u == (gen + 1u) * nloc) {
            __builtin_amdgcn_fence(__ATOMIC_RELEASE, "agent");
            asm volatile("s_waitcnt vmcnt(0)" ::: "memory");
            const unsigned og = xb_add(&bar[XB_TOP], 1u);
            const unsigned tg = og / nx;
            if (og + 1u == (tg + 1u) * nx) xb_add(&bar[XB_TOPGEN], 1u);
            else XB_SPIN(xb_ld(&bar[XB_TOPGEN]) == tg, bar);
            __builtin_amdgcn_fence(__ATOMIC_ACQUIRE, "agent");
            xb_add(&bar[XB_XGEN(b.x)], 1u);
            asm volatile("s_waitcnt vmcnt(0)" ::: "memory");
        } else {
            XB_SPIN(xb_ld(&bar[XB_XGEN(b.x)]) == gen, bar);
            __builtin_amdgcn_fence(__ATOMIC_ACQUIRE, "agent");
            asm volatile("s_waitcnt vmcnt(0)" ::: "memory");
        }
    }
    __syncthreads();
}


__device__ __forceinline__ Params load_params() {
    auto kp = __builtin_amdgcn_kernarg_segment_ptr(); asm volatile("" : "+s"(kp));
    Params p; __builtin_memcpy(&p, (const void*)kp, sizeof(Params)); return p;
}
__global__ void __launch_bounds__(512, 2) mk_fwd(Args a) {
    extern __shared__ __attribute__((aligned(16))) unsigned char lds[];
    const int lo = a.ph_lo, hi = a.ph_hi;
#define IN(k) (lo <= (k) && (k) < hi)
    volatile LAS unsigned* xbw = (volatile LAS unsigned*)((LAS unsigned char*)lds + (LDS_BYTES - 16));
    if (threadIdx.x < 4) xbw[threadIdx.x] = 0u;
    __syncthreads();
    XcdBarrier bar; bar.bar = (unsigned*)a.p.ws; bar.x = 0; bar.st = xbw;
    if (hi - lo > 1) bar = xcd_barrier_post((unsigned*)a.p.ws, xbw);
#define SEAM(k) do { if (IN(k) && IN((k) + 1)) xcd_barrier(bar); } while (0)
    if (IN(0)) { const Params p = load_params(); phase0(p, lds); }
    SEAM(0);
    if (IN(1)) { const Params p = load_params();
        if ((int)blockIdx.x < P1_WORKERS) {
        { SchedProj S; S.T.init(NTOK / 256, 6144 / 256, P1_WORKERS, blockIdx.x, 4);     EpiProj E{p.P(), p.biasP(), 1.0f};
          pg8::gemm_phase<EpiProj, SchedProj>((LAS unsigned char*)lds, p.XN(), p.WinT(), 2048, S, E); }
        { SchedGate8 S; S.T.init(NTOK / 256, 4096 / 256, P1_WORKERS, blockIdx.x, 4); EpiProj E{p.P(), p.biasP(), 1.0f / W8_SCALE};
          pg8::gemm_phase<EpiProj, SchedGate8, 1>((LAS unsigned char*)lds, p.XN8(), p.WG8T(), 2048, S, E); }
        if (blockIdx.x < 128) proj_meta(p, blockIdx.x, (float*)lds); }
        else convert_ring(p, lds, (int)blockIdx.x - P1_WORKERS, NWG - P1_WORKERS); }
    SEAM(1);
    if (IN(2)) { const Params p = load_params(); mls::m0_conv_gates(p); phase_attn(p, lds); }
    SEAM(2);
    if (IN(3)) { const Params p = load_params(); phase_yda(p); mls::m1_summaries(p, lds); }
    SEAM(3);
    if (IN(4)) { const Params p = load_params(); mls::m2_scan(p); }
    SEAM(4);
    if (IN(5)) { const Params p = load_params(); mls::m3_outputs(p, lds); }
    SEAM(5);
    if (IN(6)) { const Params p = load_params(); SchedBranch S; S.T.init(NTOK / 256, D / 256, gridDim.x, blockIdx.x); EpiBranch E{p.MIX(), p.P()};
        pg8::gemm_phase<EpiBranch, SchedBranch>((LAS unsigned char*)lds, p.YDM(), p.WbrT(), 1024, S, E); }
    SEAM(6);
    if (IN(7)) { const Params p = load_params(); SchedOut S; S.T.init(NTOK / 256, D / 256, gridDim.x, blockIdx.x); EpiOut E{p.x, p.H1()};
        pg8::gemm_phase<EpiOut, SchedOut>((LAS unsigned char*)lds, p.MIX(), p.WoutT(), 2048, S, E); }
    SEAM(7);
    if (IN(8)) { const Params p = load_params(); phase_router(p, lds); }
    SEAM(8);
    if (IN(9)) { const Params& p = a.p; moe_tables<16>(p, lds); SchedMoe1 S{(const LAS int*)((LAS unsigned char*)lds + MT_OFF)}; EpiSwiglu E{p.ACT(), (const LAS float*)((LAS unsigned char*)lds + MT_OFF) + MT_BIAS};
        pg8::gemm_phase<EpiSwiglu, SchedMoe1, 1>((LAS unsigned char*)lds, p.HN(), p.W1T(), 2048, S, E); }
    SEAM(9);
    if (IN(10)) { const Params p = load_params(); moe_tables<8>(p, lds); SchedMoe2 S{(const LAS int*)((LAS unsigned char*)lds + MT_OFF)}; EpiY E{p.Y(), (const LAS float*)((LAS unsigned char*)lds + MT_OFF) + MT_BIAS};
        pg8::gemm_phase<EpiY, SchedMoe2, 1>((LAS unsigned char*)lds, p.ACT(), p.W2T(), 2048, S, E); }
    SEAM(10);
    if (IN(11)) { const Params p = load_params(); phase_final(p); }
#undef SEAM
#undef IN
}

static void launch_mk(hipStream_t st, const Params& p, int lo, int hi) {
    Args a{}; a.p = p; a.ph_lo = lo; a.ph_hi = hi;
    hipLaunchKernelGGL(mk_fwd, dim3(NWG), dim3(512), LDS_BYTES, st, a);
}

extern "C" void kernel_launch(void* const* d_in, const int* in_sizes, int n_in, void* d_out, int out_size, void* d_ws, size_t ws_size, hipStream_t stream) {
    static int ready = 0;
    if (!ready) {
        if (hipFuncSetAttribute((const void*)mk_fwd, hipFuncAttributeMaxDynamicSharedMemorySize, LDS_BYTES) != hipSuccess) { fprintf(stderr, "kernel_launch: hipFuncSetAttribute failed\n"); return; }
        ready = 1;
    }
    Params p{};
    p.x = (const float*)d_in[0]; p.meta = (const float*)d_in[1]; p.rel_bias = (const float*)d_in[2];
    p.norm_mix = (const float*)d_in[3]; p.w_in = (const float*)d_in[4]; p.conv_w = (const float*)d_in[5];
    p.gate_bias = (const float*)d_in[6]; p.lamp = (const float*)d_in[7]; p.subln = (const float*)d_in[8];
    p.w_bda = (const float*)d_in[9]; p.w_bm = (const float*)d_in[10]; p.w_gate = (const float*)d_in[11];
    p.b_gate = (const float*)d_in[12]; p.w_out = (const float*)d_in[13]; p.norm_ffn = (const float*)d_in[14];
    p.w_router = (const float*)d_in[15]; p.b_router = (const float*)d_in[16]; p.w1 = (const float*)d_in[17];
    p.b1 = (const float*)d_in[18]; p.w2 = (const float*)d_in[19]; p.b2 = (const float*)d_in[20];
    p.norm_final = (const float*)d_in[21];
    p.out = (float*)d_out;
    size_t off = 0;
    p.ws = (unsigned char*)d_ws; off = WS_END;
    if (off > ws_size) { fprintf(stderr, "kernel_launch: workspace too small: need %zu have %zu\n", off, ws_size); return; }
    if (hipMemsetAsync(p.ctl(), 0, 65536, stream) != hipSuccess) { fprintf(stderr, "kernel_launch: memset failed\n"); return; }
#ifndef PROBE_DUP_MASK
    launch_mk(stream, p, 0, 12);
#else
    for (int ph = 0; ph < 12; ++ph) { launch_mk(stream, p, ph, ph + 1); if (((PROBE_DUP_MASK) >> ph) & 1) launch_mk(stream, p, ph, ph + 1); }
#endif
}
```

```cpp
#include <hip/hip_runtime.h>
#include <cstdio>
#include <cstdint>

constexpr int NB = 2, SEQ = 4096, D = 2048, NMETA = 16, PADF = 112, L = 4112, LP = 4224, R = NB * LP;
constexpr int INC = 6160;
constexpr int C_DAQ = 0, C_DAK = 1024, C_DAV = 2048, C_MQ = 3072, C_MK = 3584, C_MV = 4096, C_MO = 5120, C_MG = 6144;
constexpr int NE = 32, TOPK = 4, DFF = 2048;
constexpr float EPS = 1e-6f;
constexpr int MAXSLOT = R * TOPK;

__device__ __forceinline__ float wave_sum(float v) { for (int o = 32; o >= 1; o >>= 1) v += __shfl_xor(v, o); return v; }
__device__ __forceinline__ float wave_max(float v) { for (int o = 32; o >= 1; o >>= 1) v = fmaxf(v, __shfl_xor(v, o)); return v; }
__device__ __forceinline__ float block_sum256(float v, float* red) {
    v = wave_sum(v); __syncthreads(); if ((threadIdx.x & 63) == 0) red[threadIdx.x >> 6] = v; __syncthreads();
    return red[0] + red[1] + red[2] + red[3];
}
__device__ __forceinline__ float block_max256(float v, float* red) {
    v = wave_max(v); __syncthreads(); if ((threadIdx.x & 63) == 0) red[threadIdx.x >> 6] = v; __syncthreads();
    return fmaxf(fmaxf(red[0], red[1]), fmaxf(red[2], red[3]));
}
__device__ __forceinline__ float sigmoidf_(float x) { return 1.0f / (1.0f + __expf(-x)); }
__device__ __forceinline__ float logsigmoidf_(float x) { return fminf(x, 0.f) - log1pf(__expf(-fabsf(x))); }
__device__ __forceinline__ int t5_bucket(int rel) {
    const int n = rel < 0 ? -rel : rel; int v;
    if (n < 8) v = n; else { const int t = n * n; int k = 0; while (k < 7 && t >= (128 << k)) ++k; v = 8 + k; if (v > 15) v = 15; }
    return v + (rel > 0 ? 16 : 0);
}

#define LAS __attribute__((address_space(3)))
typedef unsigned short bf16_t;
typedef short bf16x8 __attribute__((ext_vector_type(8)));
typedef float f32x4 __attribute__((ext_vector_type(4)));
typedef float f32x2 __attribute__((ext_vector_type(2)));
typedef unsigned u32x4 __attribute__((ext_vector_type(4)));
typedef unsigned u32x2 __attribute__((ext_vector_type(2)));
constexpr int NPROJ = 10240;
constexpr int LDS_BYTES = 163840;
constexpr int NWG = 256;
#ifndef P1_WORKERS_
#define P1_WORKERS_ 144
#endif
constexpr int P1_WORKERS = P1_WORKERS_;
constexpr int NTOK = NB * SEQ;
constexpr int ECAP = 8192;
constexpr int MOE_ROWS = NTOK * TOPK + NE * 256;
constexpr int TAB_OFF = 131072;

__device__ __forceinline__ int otid() { int t = threadIdx.x; asm volatile("" : "+v"(t)); return t; }
__device__ __forceinline__ unsigned cvt_pk_bf16(float lo, float hi) { unsigned r; asm volatile("v_cvt_pk_bf16_f32 %0, %1, %2" : "=v"(r) : "v"(lo), "v"(hi)); return r; }
__device__ __forceinline__ unsigned pk4_fp8(float a, float b, float c, float d) { int w = __builtin_amdgcn_cvt_pk_fp8_f32(a, b, 0, false); w = __builtin_amdgcn_cvt_pk_fp8_f32(c, d, w, true); return (unsigned)w; }
typedef int i32x8 __attribute__((ext_vector_type(8)));
constexpr float W8_SCALE = 64.0f;
__device__ __forceinline__ float bf2f(bf16_t b) { return __uint_as_float(((unsigned)b) << 16); }
__device__ __forceinline__ float bflo(unsigned w) { return __uint_as_float(w << 16); }
__device__ __forceinline__ float bfhi(unsigned w) { return __uint_as_float(w & 0xffff0000u); }

constexpr size_t al256(size_t x) { return (x + 255) / 256 * 256; }
constexpr size_t WS_CTL = 0;
constexpr size_t WS_WINT = WS_CTL + 65536;
constexpr size_t WS_WBRT = WS_WINT + al256((size_t)NPROJ * 2048 * 2);
constexpr size_t WS_WOUTT = WS_WBRT + al256((size_t)4096 * 1024 * 2);
constexpr size_t WS_W1T = WS_WOUTT + al256((size_t)2048 * 2048 * 2);
constexpr size_t WS_W2T = WS_W1T + al256((size_t)NE * 4096 * 2048 * 2);
constexpr size_t WS_XN = WS_W2T + al256((size_t)NE * 2048 * 2048 * 2);
constexpr size_t WS_GATES = WS_XN + al256((size_t)R * D * 2);
constexpr size_t WS_BIASP = WS_GATES + al256((size_t)R * 16 * 4);
constexpr size_t WS_P = WS_BIASP + al256((size_t)NPROJ * 4);
constexpr size_t WS_YDM = WS_P + al256((size_t)R * NPROJ * 2);
constexpr size_t WS_OS = WS_YDM + al256((size_t)2 * NTOK * 1024 * 2);
constexpr size_t WS_TMIX = WS_OS + al256((size_t)NTOK * 1024 * 4);
constexpr size_t WS_MIX = WS_TMIX + al256((size_t)NTOK * D * 4);
constexpr size_t WS_H1 = WS_MIX + al256((size_t)NTOK * D * 2);
constexpr size_t WS_HN = WS_H1 + al256((size_t)NTOK * D * 4);
constexpr size_t WS_TOPW = WS_HN + al256((size_t)NTOK * D * 2);
constexpr size_t WS_DEST = WS_TOPW + al256((size_t)NTOK * 4 * 4);
constexpr size_t WS_LIST = WS_DEST + al256((size_t)NTOK * 4 * 4);
constexpr size_t WS_ACT = WS_LIST + al256((size_t)NE * ECAP * 4);
constexpr size_t WS_Y = WS_ACT + al256((size_t)MOE_ROWS * DFF * 2);
constexpr size_t WS_QC = WS_Y + al256((size_t)MOE_ROWS * D * 2);
constexpr size_t WS_KC = WS_QC + al256((size_t)R * 512 * 2);
constexpr size_t WS_GB = WS_KC + al256((size_t)R * 512 * 2);
constexpr size_t WS_GA = WS_GB + al256((size_t)16 * LP * 4);
constexpr size_t WS_GPM = WS_GA + al256((size_t)16 * LP * 4);
constexpr size_t WS_CS = WS_GPM + al256((size_t)16 * LP * 4);
constexpr size_t WS_DC = WS_CS + al256((size_t)16 * 33 * 2 * 4);
constexpr size_t WS_DN = WS_DC + al256((size_t)16 * 33 * 128 * 256 * 4);
constexpr size_t WS_CST = WS_DN + al256((size_t)16 * 33 * 128 * 4);
constexpr size_t WS_NST = WS_CST + al256((size_t)16 * 33 * 128 * 256 * 2);
constexpr size_t WS_MST = WS_NST + al256((size_t)16 * 33 * 128 * 4);
constexpr size_t WS_HS = WS_MST + al256((size_t)16 * 33 * 4);
constexpr size_t WS_MTAB = WS_HS + al256((size_t)NTOK * 1024 * 4);
constexpr size_t WS_XN8 = WS_MTAB + al256((size_t)2 * NWG * 512 * 4);
constexpr size_t WS_WG8T = WS_XN8 + al256((size_t)R * D);
constexpr size_t WS_END = WS_WG8T + al256((size_t)4096 * 2048);
struct Params {
    const float *x, *meta, *rel_bias, *norm_mix, *w_in, *conv_w, *gate_bias, *lamp, *subln, *w_bda, *w_bm, *w_gate, *b_gate, *w_out, *norm_ffn, *w_router, *b_router, *w1, *b1, *w2, *b2, *norm_final;
    float* out; unsigned char* ws;
#define WSP(name, T, off) __device__ __host__ __forceinline__ T* name() const { return (T*)(ws + (off)); }
    WSP(ctl, unsigned, WS_CTL) WSP(cursor, int, WS_CTL + 16384)
    WSP(WinT, bf16_t, WS_WINT) WSP(WbrT, bf16_t, WS_WBRT) WSP(WoutT, bf16_t, WS_WOUTT) WSP(W1T, bf16_t, WS_W1T) WSP(W2T, bf16_t, WS_W2T)
    WSP(XN, bf16_t, WS_XN) WSP(gates, float, WS_GATES) WSP(biasP, float, WS_BIASP) WSP(P, bf16_t, WS_P) WSP(YDM, bf16_t, WS_YDM) WSP(OS, float, WS_OS) WSP(Tmix, float, WS_TMIX)
    WSP(MIX, bf16_t, WS_MIX) WSP(H1, bf16_t, WS_H1) WSP(HN, bf16_t, WS_HN) WSP(topW, float, WS_TOPW) WSP(dest, int, WS_DEST) WSP(list, int, WS_LIST) WSP(ACT, bf16_t, WS_ACT) WSP(Y, bf16_t, WS_Y)
    WSP(Qc, bf16_t, WS_QC) WSP(Kc, bf16_t, WS_KC) WSP(GB, float, WS_GB) WSP(GA, float, WS_GA) WSP(GPM, float, WS_GPM) WSP(CS, float, WS_CS) WSP(DC, float, WS_DC) WSP(DN, float, WS_DN)
    WSP(Cst, bf16_t, WS_CST) WSP(Nst, float, WS_NST) WSP(Mst, float, WS_MST) WSP(HS, float, WS_HS) WSP(mtab, int, WS_MTAB) WSP(XN8, unsigned char, WS_XN8) WSP(WG8T, unsigned char, WS_WG8T)
#undef WSP
};
struct Args { Params p; int ph_lo, ph_hi; };

__device__ __forceinline__ int tok2prow(int tok) { return (tok >> 12) * LP + PADF + NMETA + (tok & 4095); }
namespace pg8 {
constexpr int BM = 256, BK = 64, HALF = 128, HTB = HALF * BK * 2, STAGE_BYTES = 8 * HTB, NXCD = 8, WGM = 8;
__host__ __device__ __forceinline__ int lds_byte(int r, int c) { const int st = (r >> 4) * 2 + (c >> 5), rr = r & 15, cc = c & 31, ob = rr * 64 + cc * 2; return st * 1024 + (ob ^ (((ob >> 9) & 1) << 5)); }
__host__ __device__ __forceinline__ void stage_rc(int b, int& Rr, int& C) { const int st = b / 1024, sb = b % 1024, swz = sb ^ (((sb >> 9) & 1) << 5); Rr = (st >> 1) * 16 + swz / 64; C = (st & 1) * 32 + (swz % 64) / 2; }
__host__ __device__ __forceinline__ int perm32(int rho) { const int n = rho >> 4, i = rho & 15; return 8 * (i >> 2) + 4 * n + (i & 3); }
struct Unit { int a0, b0, r0, c0, aux, nv, rot, bo; };
struct PF { unsigned a, b, c, d; };
struct TileOrder {
    int nM, nN, nwg, G, c, wgm;
    __device__ void init(int nM_, int nN_, int G_, int c_, int wgm_ = WGM) { nM = nM_; nN = nN_; nwg = nM * nN; G = G_; c = c_; wgm = wgm_; }
    __device__ bool tile(int i, int& pm, int& pn) const {
        const long Lx = (long)i * G + c; if (Lx >= nwg) return false;
        int wgid = (int)Lx; { const int q = nwg / NXCD, r = nwg % NXCD, xcd = wgid % NXCD, off = wgid / NXCD; wgid = (xcd < r ? xcd * (q + 1) : r * (q + 1) + (xcd - r) * q) + off; }
        const int nig = wgm * nN, gid = wgid / nig, fm = gid * wgm, gsz = (nM - fm) < wgm ? (nM - fm) : wgm;
        pm = fm + ((wgid % nig) % gsz); pn = (wgid % nig) / gsz; return true;
    }
};
template <class Epi, class Sched, int ES = 2>
__device__ __forceinline__ void gemm_phase(LAS unsigned char* lds, const void* A, const void* Bt, const int K, const Sched& S, const Epi& E) {
    const int tid = threadIdx.x, wid = __builtin_amdgcn_readfirstlane(tid >> 6), lane = tid & 63, wr = wid >> 2, wc = wid & 3, fr = lane & 15, fq = lane >> 4;
    const int nt = K * ES / 128;
    unsigned voffA[2], voffB[2];
#pragma unroll
    for (int i = 0; i < 2; ++i) { int Rr, C; stage_rc(tid * 16 + i * 8192, Rr, C); const int Rb = Epi::PERM ? ((Rr & ~31) + perm32(Rr & 31)) : Rr;
        voffA[i] = (unsigned)(Rr * K * ES + C * 2); voffB[i] = Sched::BTILED ? (unsigned)(Rb * 128 + C * 2) : (unsigned)(Rb * K * ES + C * 2); }
    const size_t kstep = (size_t)(BK * 2);
    const size_t hstep = (size_t)HALF * K * ES;
    const size_t kstepB = Sched::BTILED ? (size_t)32768 : kstep, hstepB = Sched::BTILED ? (size_t)(HALF * 128) : hstep;
    const size_t rstep = (size_t)K * ES;
    const unsigned ldsw = (unsigned)wid * 1024u;
    const int aoff = ES == 2 ? lds_byte(wr * 64 + fr, fq * 8) : lds_byte(wr * 64 + fr, fq * 16), boff = ES == 2 ? lds_byte(wc * 32 + fr, fq * 8) : lds_byte(wc * 32 + fr, fq * 16);
#define PG8_SA(b, h) (((b) * 2 + (h)) * HTB)
#define PG8_SB(b, h) ((4 + (b) * 2 + (h)) * HTB)
#define PG8_STAGE(bufoff, gbase, voff) do { _Pragma("unroll") for (int _i = 0; _i < 2; ++_i) \
        __builtin_amdgcn_global_load_lds((const unsigned*)((const char*)(gbase) + (voff)[_i]), (LAS unsigned*)(lds + (bufoff) + ldsw + _i * 8192), 16, 0, 0); } while (0)
#define PG8_LD32(ptr) __builtin_bit_cast(i32x8, __builtin_shufflevector(*(const LAS u32x4*)(ptr), *(const LAS u32x4*)((ptr) + 16), 0, 1, 2, 3, 4, 5, 6, 7))
#define PG8_LDA(dst, b, h) do { if constexpr (ES == 2) { _Pragma("unroll") for (int m = 0; m < 4; ++m) _Pragma("unroll") for (int k = 0; k < 2; ++k) dst[m][k] = *(const LAS bf16x8*)(lds + PG8_SA(b, h) + aoff + m * 2048 + k * 1024); } \
        else { _Pragma("unroll") for (int m = 0; m < 4; ++m) dst##8[m] = PG8_LD32(lds + PG8_SA(b, h) + aoff + m * 2048); } } while (0)
#define PG8_LDB(dst, b, h) do { if constexpr (ES == 2) { _Pragma("unroll") for (int n = 0; n < 2; ++n) _Pragma("unroll") for (int k = 0; k < 2; ++k) dst[n][k] = *(const LAS bf16x8*)(lds + PG8_SB(b, h) + boff + n * 2048 + k * 1024); } \
        else { _Pragma("unroll") for (int n = 0; n < 2; ++n) dst##8[n] = PG8_LD32(lds + PG8_SB(b, h) + boff + n * 2048); } } while (0)
#define PG8_MMA(ai, bj, At, Bt_) do { int sc127_ = 127; if constexpr (ES == 1) asm volatile("" : "+v"(sc127_)); __builtin_amdgcn_s_setprio(1); if constexpr (ES == 2) { _Pragma("unroll") for (int m = 0; m < 4; ++m) _Pragma("unroll") for (int n = 0; n < 2; ++n) _Pragma("unroll") for (int k = 0; k < 2; ++k) \
        acc[ai][bj][m][n] = __builtin_amdgcn_mfma_f32_16x16x32_bf16(Bt_[n][k], At[m][k], acc[ai][bj][m][n], 0, 0, 0); } else { _Pragma("unroll") for (int m = 0; m < 4; ++m) _Pragma("unroll") for (int n = 0; n < 2; ++n) \
        asm volatile("v_mfma_scale_f32_16x16x128_f8f6f4 %0, %1, %2, %0, %3, %3 op_sel_hi:[0,0,0]" : "+v"(acc[ai][bj][m][n]) : "v"(Bt_##8[n]), "v"(At##8[m]), "v"(sc127_)); } __builtin_amdgcn_s_setprio(0); } while (0)
#define PG8_WAIT_V(n) asm volatile("s_waitcnt vmcnt(" #n ")" ::: "memory")
#define PG8_WAIT_L(n) asm volatile("s_waitcnt lgkmcnt(" #n ")" ::: "memory")
#define PG8_BAR __builtin_amdgcn_s_barrier()
#define PG8_SCHED __builtin_amdgcn_sched_barrier(0)
    Unit cur, nxt; int ui = 0;
    if (!S.next(0, cur)) return;
    f32x4 acc[2][2][4][2];
#pragma unroll
    for (int a = 0; a < 2; ++a)
#pragma unroll
        for (int b = 0; b < 2; ++b)
#pragma unroll
            for (int m = 0; m < 4; ++m)
#pragma unroll
                for (int n = 0; n < 2; ++n) acc[a][b][m][n] = (f32x4){0.f, 0.f, 0.f, 0.f};
    bf16x8 At[4][2], B0[2][2], B1[2][2]; i32x8 At8[4], B08[2], B18[2];
    unsigned vgc[2][2], vgn[2][2];
#define PG8_GOFF(dst, u) do { _Pragma("unroll") for (int _h = 0; _h < 2; ++_h) _Pragma("unroll") for (int _i = 0; _i < 2; ++_i) { int Rr, C; stage_rc(tid * 16 + _i * 8192, Rr, C); \
        dst[_h][_i] = (unsigned)((size_t)S.arow(u, _h * HALF + Rr) * (size_t)K * ES + C * 2); } } while (0)
#define PG8_STA(b, h, PTR, NEXTSEL) do { if constexpr (Sched::GATHER) { if (NEXTSEL) PG8_STAGE(PG8_SA(b, h), PTR, vgn[h]); else PG8_STAGE(PG8_SA(b, h), PTR, vgc[h]); } \
        else PG8_STAGE(PG8_SA(b, h), (PTR) + (h) * hstep, voffA); } while (0)
    const char* cA = Sched::GATHER ? (const char*)A : (const char*)A + (size_t)cur.a0 * rstep; const char* cB = (const char*)Bt + (size_t)cur.b0 * rstep;
    if constexpr (Sched::GATHER) { PG8_GOFF(vgc, cur); }
    const int ntm = nt - 1;
#define PG8_KT(u, t) ((size_t)(((t) + (u).rot) & ntm) * kstep)
#define PG8_KTB(u, t) ((size_t)(((t) + (u).rot) & ntm) * kstepB)
    PG8_STAGE(PG8_SB(0, 0), cB + PG8_KTB(cur, 0), voffB); PG8_STA(0, 0, cA + PG8_KT(cur, 0), false); PG8_STAGE(PG8_SB(0, 1), cB + hstepB + PG8_KTB(cur, 0), voffB); PG8_STA(0, 1, cA + PG8_KT(cur, 0), false);
    if (wr == 1) PG8_BAR;
    PG8_WAIT_V(4); PG8_BAR;
    PG8_STAGE(PG8_SB(1, 0), cB + PG8_KTB(cur, 1), voffB); PG8_STA(1, 0, cA + PG8_KT(cur, 1), false); PG8_STAGE(PG8_SB(1, 1), cB + hstepB + PG8_KTB(cur, 1), voffB);
    PG8_WAIT_V(6); PG8_BAR;
    const PF pf = E.prefetch(cur, tid);
    for (;;) {
        const bool has_next = S.next(ui + 1, nxt);
        const char* nA = Sched::GATHER ? cA : (has_next ? (const char*)A + (size_t)nxt.a0 * rstep : cA); const char* nB = has_next ? (const char*)Bt + (size_t)nxt.b0 * rstep : cB;
        if constexpr (Sched::GATHER) { if (has_next) { PG8_GOFF(vgn, nxt); } else {
#pragma unroll
            for (int _h = 0; _h < 2; ++_h) { vgn[_h][0] = vgc[_h][0]; vgn[_h][1] = vgc[_h][1]; } }
            asm volatile("" : "+v"(vgn[0][0]), "+v"(vgn[0][1]), "+v"(vgn[1][0]), "+v"(vgn[1][1])); }
        for (int t = 0; t < nt; t += 2) {
            const bool last = (t == nt - 2);
            const Unit& un = has_next ? nxt : cur;
            const char* a1 = cA + PG8_KT(cur, t + 1); const char* b1 = cB + PG8_KTB(cur, t + 1);
            const char* a2 = last ? nA + PG8_KT(un, 0) : cA + PG8_KT(cur, t + 2); const char* b2 = last ? nB + PG8_KTB(un, 0) : cB + PG8_KTB(cur, t + 2);
            const char* a3 = last ? nA + PG8_KT(un, 1) : cA + PG8_KT(cur, t + 3); const char* b3 = last ? nB + PG8_KTB(un, 1) : cB + PG8_KTB(cur, t + 3); (void)b1;
            PG8_LDB(B0, 0, 0); PG8_SCHED; PG8_LDA(At, 0, 0); PG8_STA(1, 1, a1, false);
            PG8_WAIT_L(8); PG8_BAR; PG8_WAIT_L(0); PG8_MMA(0, 0, At, B0); PG8_BAR; PG8_SCHED;
            PG8_LDB(B1, 0, 1); PG8_STAGE(PG8_SB(0, 0), b2, voffB);
            PG8_BAR; PG8_WAIT_L(0); PG8_MMA(0, 1, At, B1); PG8_BAR;
            PG8_LDA(At, 0, 1); PG8_STA(0, 0, a2, last);
            PG8_BAR; PG8_WAIT_L(0); PG8_MMA(1, 0, At, B0); PG8_BAR; PG8_SCHED;
            PG8_STAGE(PG8_SB(0, 1), b2 + hstepB, voffB);
            PG8_WAIT_V(6); PG8_BAR; PG8_MMA(1, 1, At, B1); PG8_BAR;
            PG8_LDB(B0, 1, 0); PG8_SCHED; PG8_LDA(At, 1, 0); PG8_STA(0, 1, a2, last);
            PG8_WAIT_L(8); PG8_BAR; PG8_WAIT_L(0); PG8_MMA(0, 0, At, B0); PG8_BAR; PG8_SCHED;
            PG8_LDB(B1, 1, 1); PG8_STAGE(PG8_SB(1, 0), b3, voffB);
            PG8_BAR; PG8_WAIT_L(0); PG8_MMA(0, 1, At, B1); PG8_BAR;
            PG8_LDA(At, 1, 1); PG8_STA(1, 0, a3, last);
            PG8_BAR; PG8_WAIT_L(0); PG8_MMA(1, 0, At, B0); PG8_BAR; PG8_SCHED;
            PG8_STAGE(PG8_SB(1, 1), b3 + hstepB, voffB);
            PG8_WAIT_V(6); PG8_BAR; PG8_MMA(1, 1, At, B1); PG8_BAR;
        }
        asm volatile("" :: "v"(pf.a), "v"(pf.b), "v"(pf.c), "v"(pf.d));
        if constexpr (ES == 1) asm volatile("s_nop 15\n\ts_nop 15" ::: "memory");
        E(acc, cur, wr, wc, fr, fq);
        if (!has_next) break;
        if (!E.keep(cur)) {
#pragma unroll
        for (int a = 0; a < 2; ++a)
#pragma unroll
            for (int b = 0; b < 2; ++b)
#pragma unroll
                for (int m = 0; m < 4; ++m)
#pragma unroll
                    for (int n = 0; n < 2; ++n) acc[a][b][m][n] = (f32x4){0.f, 0.f, 0.f, 0.f}; }
        cur = nxt; cA = nA; cB = nB; ++ui;
        if constexpr (Sched::GATHER) {
#pragma unroll
            for (int _h = 0; _h < 2; ++_h) { vgc[_h][0] = vgn[_h][0]; vgc[_h][1] = vgn[_h][1]; } }
    }
    PG8_WAIT_V(0);
    if (wr == 0) PG8_BAR;
    PG8_BAR;
#undef PG8_SA
#undef PG8_LD32
#undef PG8_KT
#undef PG8_KTB
#undef PG8_GOFF
#undef PG8_STA
#undef PG8_SB
#undef PG8_STAGE
#undef PG8_LDA
#undef PG8_LDB
#undef PG8_MMA
#undef PG8_WAIT_V
#undef PG8_WAIT_L
#undef PG8_BAR
#undef PG8_SCHED
}
}

struct SchedProj { static constexpr bool BTILED = false; static constexpr bool GATHER = false; pg8::TileOrder T;
    __device__ int arow(const pg8::Unit&, int) const { return 0; }
    __device__ bool next(int i, pg8::Unit& u) const { int pm, pn; if (!T.tile(i, pm, pn)) return false; u.a0 = tok2prow(pm * 256); u.b0 = pn * 256; u.r0 = u.a0; u.c0 = pn * 256; u.aux = 0; u.nv = 256; u.rot = 0; return true; } };
struct EpiProj { __device__ __forceinline__ pg8::PF prefetch(const pg8::Unit&, int) const { return pg8::PF{0u, 0u, 0u, 0u}; } __device__ __forceinline__ bool keep(const pg8::Unit&) const { return false; } static constexpr bool PERM = true; bf16_t* P; const float* bias; float scale;
    __device__ __forceinline__ void operator()(f32x4 (&acc)[2][2][4][2], const pg8::Unit& u, int wr, int wc, int fr, int fq) const {
        const int row0 = u.r0 + wr * 64 + fr, col0 = u.c0 + wc * 32 + 8 * fq; const bool sig = u.c0 >= 6144;
        f32x4 bv[2][2];
#pragma unroll
        for (int bj = 0; bj < 2; ++bj)
#pragma unroll
            for (int n = 0; n < 2; ++n) bv[bj][n] = sig ? *(const f32x4*)(bias + col0 + bj * 128 + 4 * n) : (f32x4){0.f, 0.f, 0.f, 0.f};
#pragma unroll
        for (int ai = 0; ai < 2; ++ai)
#pragma unroll
            for (int m = 0; m < 4; ++m) { bf16_t* rowp = P + (size_t)(row0 + ai * 128 + m * 16) * NPROJ + col0;
#pragma unroll
                for (int bj = 0; bj < 2; ++bj) { f32x4 v0 = acc[ai][bj][m][0] * scale + bv[bj][0], v1 = acc[ai][bj][m][1] * scale + bv[bj][1];
                    if (sig) {
#pragma unroll
                        for (int j = 0; j < 4; ++j) { v0[j] = __builtin_amdgcn_rcpf(1.0f + __expf(-v0[j])); v1[j] = __builtin_amdgcn_rcpf(1.0f + __expf(-v1[j])); } }
                    u32x4 w; w.x = cvt_pk_bf16(v0[0], v0[1]); w.y = cvt_pk_bf16(v0[2], v0[3]); w.z = cvt_pk_bf16(v1[0], v1[1]); w.w = cvt_pk_bf16(v1[2], v1[3]);
                    *(u32x4*)(rowp + bj * 128) = w; } }
    }
};


struct SchedGate8 { static constexpr bool BTILED = true; static constexpr bool GATHER = false; pg8::TileOrder T;
    __device__ bool next(int i, pg8::Unit& u) const { int pm, pn; if (!T.tile(i, pm, pn)) return false; u.a0 = tok2prow(pm * 256); u.b0 = pn * 256; u.r0 = u.a0; u.c0 = 6144 + pn * 256; u.aux = 0; u.nv = 256; u.rot = 0; return true; }
    __device__ int arow(const pg8::Unit&, int) const { return 0; } };

__device__ __forceinline__ void proj_meta(const Params& p, const int task, float* red) {
    const int tid = otid(), wid = tid >> 6, lane = tid & 63, r16 = lane & 15, g = lane >> 4, c0 = 1024 + task * 32;
    const bf16_t* ap = p.XN() + (size_t)(PADF + r16) * D + wid * 256 + 8 * g;
    const bf16_t* bp0 = p.WinT() + (size_t)(c0 + r16) * D + wid * 256 + 8 * g; const bf16_t* bp1 = bp0 + (size_t)16 * D;
    bf16x8 a[8], b0[8], b1[8];
#pragma unroll
    for (int ks = 0; ks < 8; ++ks) { a[ks] = *reinterpret_cast<const bf16x8*>(ap + ks * 32); b0[ks] = *reinterpret_cast<const bf16x8*>(bp0 + ks * 32); b1[ks] = *reinterpret_cast<const bf16x8*>(bp1 + ks * 32); }
    f32x4 acc0 = {0.f, 0.f, 0.f, 0.f}, acc1 = {0.f, 0.f, 0.f, 0.f};
#pragma unroll
    for (int ks = 0; ks < 8; ++ks) { acc0 = __builtin_amdgcn_mfma_f32_16x16x32_bf16(a[ks], b0[ks], acc0, 0, 0, 0); acc1 = __builtin_amdgcn_mfma_f32_16x16x32_bf16(a[ks], b1[ks], acc1, 0, 0, 0); }
    *(f32x4*)(red + ((wid * 2 + 0) * 64 + lane) * 4) = acc0; *(f32x4*)(red + ((wid * 2 + 1) * 64 + lane) * 4) = acc1;
    __syncthreads();
    { const int l2 = tid & 63, blk = (tid >> 6) & 1, reg = tid >> 7; float v = 0.f;
#pragma unroll
      for (int w = 0; w < 8; ++w) v += red[((w * 2 + blk) * 64 + l2) * 4 + reg];
      const int row = PADF + 4 * (l2 >> 4) + reg, col = c0 + 16 * blk + (l2 & 15); const bf16_t o = (bf16_t)(cvt_pk_bf16(v, 0.f) & 0xffffu);
#pragma unroll
      for (int b = 0; b < NB; ++b) p.P()[(size_t)(b * LP + row) * NPROJ + col] = o; }
    __syncthreads();
}

struct CvtTile { const float* src; bf16_t* dst; int ld, K, f8; };
constexpr int CVT_NT = 1536 + 1024 + 512 + 512 + 32768 + 16384;
__device__ __forceinline__ CvtTile cvt_desc(const Params& p, int t) {
    CvtTile d;
    if (t < 1536) { const int nt = t / 16, kt = t % 16; d.src = p.w_in + (size_t)kt * 128 * INC + nt * 64; d.dst = p.WinT() + (size_t)(nt * 64) * 2048 + kt * 128; d.ld = INC; d.K = 2048; d.f8 = 0; return d; }
    t -= 1536;
    if (t < 1024) { const int nt = t / 16, kt = t % 16; d.src = p.w_gate + (size_t)kt * 128 * 4096 + nt * 64; d.dst = (bf16_t*)(p.WG8T() + ((size_t)(nt >> 2) * 16 + kt) * 32768 + (nt & 3) * 8192); d.ld = 4096; d.K = 128; d.f8 = 1; return d; }
    t -= 1024;
    if (t < 512) { const int which = t / 256, t2 = t % 256, nt = t2 / 8, kt = t2 % 8; d.src = (which ? p.w_bm : p.w_bda) + (size_t)kt * 128 * 2048 + nt * 64; d.dst = p.WbrT() + (size_t)(which * 2048 + nt * 64) * 1024 + kt * 128; d.ld = 2048; d.K = 1024; d.f8 = 0; return d; }
    t -= 512;
    if (t < 512) { const int nt = t / 16, kt = t % 16; d.src = p.w_out + (size_t)kt * 128 * 2048 + nt * 64; d.dst = p.WoutT() + (size_t)(nt * 64) * 2048 + kt * 128; d.ld = 2048; d.K = 2048; d.f8 = 0; return d; }
    t -= 512;
    if (t < 32768) { const int e = t / 1024, t2 = t % 1024, nt = t2 / 16, kt = t2 % 16, blk = nt / 4, w0 = (nt % 4) * 64; const int scol = w0 < 128 ? blk * 128 + w0 : 2048 + blk * 128 + (w0 - 128);
        d.src = p.w1 + (size_t)e * 2048 * 4096 + (size_t)kt * 128 * 4096 + scol; d.dst = (bf16_t*)((unsigned char*)p.W1T() + ((size_t)(e * 16 + (nt >> 2)) * 16 + kt) * 32768 + (nt & 3) * 8192); d.ld = 4096; d.K = 128; d.f8 = 1; return d; }
    t -= 32768;
    { const int e = t / 512, t2 = t % 512, nt = t2 / 16, kt = t2 % 16; d.src = p.w2 + (size_t)e * 2048 * 2048 + (size_t)kt * 128 * 2048 + nt * 64; d.dst = (bf16_t*)((unsigned char*)p.W2T() + ((size_t)(e * 8 + (nt >> 2)) * 16 + kt) * 32768 + (nt & 3) * 8192); d.ld = 2048; d.K = 128; d.f8 = 1; return d; }
}

__device__ __forceinline__ CvtTile cvt_moe(const Params& p, int u, const int j) {
    CvtTile d; d.K = 128; d.f8 = 1;
    if (u < 8192) { const int c = u & 15, kt = (u >> 4) & 15, e = u >> 8, blk = 2 * (c & 7) + (j >> 1), nt = blk * 4 + (j & 1) + (c >= 8 ? 2 : 0);
        d.src = p.w1 + (size_t)e * 2048 * 4096 + (size_t)kt * 128 * 4096 + c * 256 + j * 64; d.dst = (bf16_t*)((unsigned char*)p.W1T() + ((size_t)(e * 16 + (nt >> 2)) * 16 + kt) * 32768 + (nt & 3) * 8192); d.ld = 4096; return d; }
    u -= 8192;
    { const int c = u & 7, kt = (u >> 3) & 15, e = u >> 7, nt = c * 4 + j;
        d.src = p.w2 + (size_t)e * 2048 * 2048 + (size_t)kt * 128 * 2048 + nt * 64; d.dst = (bf16_t*)((unsigned char*)p.W2T() + ((size_t)(e * 8 + (nt >> 2)) * 16 + kt) * 32768 + (nt & 3) * 8192); d.ld = 2048; return d; }
}
__device__ __forceinline__ void convert_ring(const Params& p, unsigned char* lds_, const int first, const int stride) {
    LAS unsigned char* lds = (LAS unsigned char*)lds_;
    const int tid = otid(), wid = __builtin_amdgcn_readfirstlane(tid >> 6), lk = tid >> 4, lq = tid & 15;
    constexpr int NSUP = 8192 + 4096;
    const int ntile = 4 * ((NSUP - first + stride - 1) / stride);
#define RING_ISSUE(i_, slot_) do { const CvtTile d_ = cvt_moe(p, first + ((i_) >> 2) * stride, (i_) & 3); _Pragma("unroll") for (int r_ = 0; r_ < 4; ++r_) { const int k_ = lk + 32 * r_; \
        __builtin_amdgcn_global_load_lds((const unsigned*)(d_.src + (size_t)k_ * d_.ld + ((lq ^ ((k_ >> 4) & 7)) << 2)), (LAS unsigned*)(lds + (slot_) * 32768 + (wid * 4 + 32 * r_) * 256), 16, 0, 2  ); } } while (0)
    if (ntile > 0) RING_ISSUE(0, 0);
    if (ntile > 1) RING_ISSUE(1, 1);
    if (ntile > 2) RING_ISSUE(2, 2);
    const int n = tid >> 3, kc = tid & 7;
    for (int it = 0; it < ntile; ++it) {
        if (it + 3 < ntile) { RING_ISSUE(it + 3, (it + 3) & 3); asm volatile("s_waitcnt vmcnt(12)" ::: "memory"); }
        else asm volatile("s_waitcnt vmcnt(0)" ::: "memory");
        __builtin_amdgcn_s_barrier();
        const CvtTile d = cvt_moe(p, first + (it >> 2) * stride, it & 3);
        const LAS float* qq = (const LAS float*)(lds + (it & 3) * 32768) + (kc * 16) * 64 + ((((n >> 2) ^ kc) << 2) | (n & 3));
        float v[16];
#pragma unroll
        for (int j = 0; j < 16; ++j) v[j] = qq[j * 64];
        asm volatile("s_waitcnt lgkmcnt(0)" ::: "memory");
        __builtin_amdgcn_s_barrier();
        u32x4 w; w.x = pk4_fp8(v[0] * W8_SCALE, v[1] * W8_SCALE, v[2] * W8_SCALE, v[3] * W8_SCALE); w.y = pk4_fp8(v[4] * W8_SCALE, v[5] * W8_SCALE, v[6] * W8_SCALE, v[7] * W8_SCALE);
        w.z = pk4_fp8(v[8] * W8_SCALE, v[9] * W8_SCALE, v[10] * W8_SCALE, v[11] * W8_SCALE); w.w = pk4_fp8(v[12] * W8_SCALE, v[13] * W8_SCALE, v[14] * W8_SCALE, v[15] * W8_SCALE);
        *(u32x4*)((unsigned char*)d.dst + (size_t)n * d.K + kc * 16) = w;
    }
    asm volatile("s_waitcnt vmcnt(0)" ::: "memory");
#undef RING_ISSUE
}
__device__ __forceinline__ void phase0(const Params& p, unsigned char* lds) {
    const int tid = otid(), wid = tid >> 6, lane = tid & 63;
    {
        float* WgT = (float*)lds;
        for (int i = tid; i < 2048 * 4; i += 512) { const int k = i >> 2, q = i & 3; const float4 w4 = *(const float4*)(p.w_in + (size_t)k * INC + 6144 + q * 4);
            WgT[(q * 4 + 0) * 2048 + k] = w4.x; WgT[(q * 4 + 1) * 2048 + k] = w4.y; WgT[(q * 4 + 2) * 2048 + k] = w4.z; WgT[(q * 4 + 3) * 2048 + k] = w4.w; }
        for (int i = blockIdx.x * 512 + tid; i < NPROJ; i += gridDim.x * 512) p.biasP()[i] = i < 6144 ? 0.f : p.b_gate[i - 6144];
        __syncthreads();
        const int rstride = gridDim.x * 8; float4 vn[8];
#define P0_SRC(rr) (((rr) % LP) >= PADF + NMETA ? p.x + ((size_t)((rr) / LP) * SEQ + (((rr) % LP) - PADF - NMETA)) * D : p.meta + (size_t)(((rr) % LP) - PADF) * D)
        { const int r0 = blockIdx.x * 8 + wid; if (r0 < R && (r0 % LP) >= PADF) { const float* s0 = P0_SRC(r0);
#pragma unroll
            for (int q = 0; q < 8; ++q) vn[q] = *(const float4*)(s0 + q * 256 + lane * 4); } }
        for (int r = blockIdx.x * 8 + wid; r < R; r += rstride) {
            const int pp = r % LP;
            float4 v[8]; float ss = 0.f;
#pragma unroll
            for (int q = 0; q < 8; ++q) v[q] = vn[q];
            { const int rn = r + rstride; if (rn < R && (rn % LP) >= PADF) { const float* s1 = P0_SRC(rn);
#pragma unroll
                for (int q = 0; q < 8; ++q) vn[q] = *(const float4*)(s1 + q * 256 + lane * 4); } }
            if (pp < PADF) {
#pragma unroll
                for (int q = 0; q < 8; ++q) { *(u32x2*)(p.XN() + (size_t)r * D + q * 256 + lane * 4) = (u32x2){0u, 0u}; *(unsigned*)(p.XN8() + (size_t)r * D + q * 256 + lane * 4) = 0u; }
                if (lane < 16) p.gates()[(size_t)r * 16 + lane] = 0.f;
                continue; }
#pragma unroll
            for (int q = 0; q < 8; ++q) ss += v[q].x * v[q].x + v[q].y * v[q].y + v[q].z * v[q].z + v[q].w * v[q].w;
            ss = wave_sum(ss); const float rs = rsqrtf(ss / D + EPS);
            float ga[16];
#pragma unroll
            for (int g = 0; g < 16; ++g) ga[g] = 0.f;
#pragma unroll
            for (int q = 0; q < 8; ++q) { const int c = q * 256 + lane * 4; const float4 gn = *(const float4*)(p.norm_mix + c);
                const float x0 = v[q].x * rs * gn.x, x1 = v[q].y * rs * gn.y, x2 = v[q].z * rs * gn.z, x3 = v[q].w * rs * gn.w;
                u32x2 w; w.x = cvt_pk_bf16(x0, x1); w.y = cvt_pk_bf16(x2, x3); *(u32x2*)(p.XN() + (size_t)r * D + c) = w; *(unsigned*)(p.XN8() + (size_t)r * D + c) = pk4_fp8(x0, x1, x2, x3);
#pragma unroll
                for (int g = 0; g < 16; ++g) { const float4 w4 = *(const float4*)(WgT + g * 2048 + c); ga[g] += x0 * w4.x + x1 * w4.y + x2 * w4.z + x3 * w4.w; } }
            float a8[8], a4[4], a2[2];
            { const bool hb = (lane >> 5) & 1;
#pragma unroll
              for (int i = 0; i < 8; ++i) { const float x = hb ? ga[i + 8] : ga[i], y = hb ? ga[i] : ga[i + 8]; a8[i] = x + __shfl_xor(y, 32); } }
            { const bool hb = (lane >> 4) & 1;
#pragma unroll
              for (int i = 0; i < 4; ++i) { const float x = hb ? a8[i + 4] : a8[i], y = hb ? a8[i] : a8[i + 4]; a4[i] = x + __shfl_xor(y, 16); } }
            { const bool hb = (lane >> 3) & 1;
#pragma unroll
              for (int i = 0; i < 2; ++i) { const float x = hb ? a4[i + 2] : a4[i], y = hb ? a4[i] : a4[i + 2]; a2[i] = x + __shfl_xor(y, 8); } }
            float a1; { const bool hb = (lane >> 2) & 1; const float x = hb ? a2[1] : a2[0], y = hb ? a2[0] : a2[1]; a1 = x + __shfl_xor(y, 4); }
            a1 += __shfl_xor(a1, 2); a1 += __shfl_xor(a1, 1);
            if ((lane & 3) == 0) p.gates()[(size_t)r * 16 + (lane >> 2)] = a1;
        }
#undef P0_SRC
        __syncthreads();
    }
    {
        float* T = (float*)lds;
        const int lk = tid >> 4, lq = tid & 15;
        f32x4 cur[4][4], nxt[4][4];
#define CVT_LOAD(buf, g) do { _Pragma("unroll") for (int q = 0; q < 4; ++q) { const CvtTile d = cvt_desc(p, (g) * 4 + q); _Pragma("unroll") for (int i = 0; i < 4; ++i) \
            buf[q][i] = __builtin_nontemporal_load((const f32x4*)(d.src + (size_t)(lk + 32 * i) * d.ld + lq * 4)); } } while (0)
        int g = blockIdx.x;
        constexpr int G_HI = P1_WORKERS == NWG ? CVT_NT / 4 : (1536 + 1024 + 512 + 512) / 4;
        if (g < G_HI) CVT_LOAD(cur, g);
        for (; g < G_HI; g += gridDim.x) {
            const int gn = g + gridDim.x;
            if (gn < G_HI) CVT_LOAD(nxt, gn);
#pragma unroll
            for (int q = 0; q < 4; ++q)
#pragma unroll
                for (int i = 0; i < 4; ++i) { float* q0 = T + q * (128 * 65) + (lk + 32 * i) * 65 + lq * 4; q0[0] = cur[q][i][0]; q0[1] = cur[q][i][1]; q0[2] = cur[q][i][2]; q0[3] = cur[q][i][3]; }
            __syncthreads();
#pragma unroll
            for (int q = 0; q < 4; ++q) { const CvtTile d = cvt_desc(p, g * 4 + q);
                if (d.f8) { const int n = tid >> 3, kc = tid & 7; const float* qq = T + q * (128 * 65) + (kc * 16) * 65 + n; u32x4 w;
                    w.x = pk4_fp8(qq[0] * W8_SCALE, qq[65] * W8_SCALE, qq[130] * W8_SCALE, qq[195] * W8_SCALE); w.y = pk4_fp8(qq[260] * W8_SCALE, qq[325] * W8_SCALE, qq[390] * W8_SCALE, qq[455] * W8_SCALE);
                    w.z = pk4_fp8(qq[520] * W8_SCALE, qq[585] * W8_SCALE, qq[650] * W8_SCALE, qq[715] * W8_SCALE); w.w = pk4_fp8(qq[780] * W8_SCALE, qq[845] * W8_SCALE, qq[910] * W8_SCALE, qq[975] * W8_SCALE);
                    *(u32x4*)((unsigned char*)d.dst + (size_t)n * d.K + kc * 16) = w;
                } else {
#pragma unroll
                for (int i = 0; i < 2; ++i) { const int ch = tid + 512 * i, n = ch >> 4, kc = ch & 15; const float* qq = T + q * (128 * 65) + (kc * 8) * 65 + n;
                    u32x4 w; w.x = cvt_pk_bf16(qq[0], qq[65]); w.y = cvt_pk_bf16(qq[130], qq[195]); w.z = cvt_pk_bf16(qq[260], qq[325]); w.w = cvt_pk_bf16(qq[390], qq[455]);
                    *(u32x4*)(d.dst + (size_t)n * d.K + kc * 8) = w; } } }
            __syncthreads();
#pragma unroll
            for (int q = 0; q < 4; ++q)
#pragma unroll
                for (int i = 0; i < 4; ++i) cur[q][i] = nxt[q][i];
        }
#undef CVT_LOAD
    }
}


namespace att {
constexpr int QBLK = 32, KVBLK = 64, NW = 8;
constexpr float SCALE = 0.088388347648318440f, THR = 8.f;
constexpr int LDQ = NPROJ, LDK = NPROJ;
constexpr int SHM_V = KVBLK * 128 * 2, SHM_K = KVBLK * 128 * 2, SHM_ATTN = 2 * SHM_V + 2 * SHM_K + NW * 64 * 4;
constexpr int TAB_B = SHM_ATTN;
using s16x4 = __attribute__((ext_vector_type(4))) short;
using f32x16 = __attribute__((ext_vector_type(16))) float;
#define KSWZ(row, colB) ((row) * 256 + ((colB) ^ (((row) & 7) << 4)))
#define SBAR() __builtin_amdgcn_sched_barrier(0)
__device__ __forceinline__ int crow(int r, int hi) { return (r & 3) + 8 * (r >> 2) + 4 * hi; }
__device__ __forceinline__ void partialSM(f32x16& p0, f32x16& p1, float& m_reg, float& mn, float& alpha, const float cadd) {
  constexpr float C = SCALE * 1.4426950408889634f;
  float pmax = p0[0]; for (int r = 1; r < 16; ++r) pmax = fmaxf(pmax, p0[r]); for (int r = 0; r < 16; ++r) pmax = fmaxf(pmax, p1[r]);
  { auto rr = __builtin_amdgcn_permlane32_swap(__float_as_uint(pmax), __float_as_uint(pmax), false, false);
    pmax = fmaxf(__uint_as_float(rr[0]), __uint_as_float(rr[1])); }
  pmax += cadd;
  if (__builtin_expect(__all(pmax - m_reg <= THR / SCALE), 1)) { mn = m_reg; alpha = 1.f; }
  else { mn = fmaxf(m_reg, pmax); alpha = __builtin_amdgcn_exp2f((m_reg - mn) * C); m_reg = mn; }
  float mnC = (cadd - mn) * C;
  for (int r = 0; r < 16; ++r) p0[r] = fmaf(p0[r], C, mnC); for (int r = 0; r < 16; ++r) p1[r] = fmaf(p1[r], C, mnC);
  for (int r = 0; r < 16; ++r) p0[r] = __builtin_amdgcn_exp2f(p0[r]);
}
__device__ __forceinline__ void finishSM(f32x16& p0, f32x16& p1, float alpha, float& l_reg, bf16x8& pa0, bf16x8& pa1, bf16x8& pa2, bf16x8& pa3) {
  for (int r = 0; r < 16; ++r) p1[r] = __builtin_amdgcn_exp2f(p1[r]);
  float ps = 0; for (int r = 0; r < 16; ++r) ps += p0[r]; for (int r = 0; r < 16; ++r) ps += p1[r];
  { auto rr = __builtin_amdgcn_permlane32_swap(__float_as_uint(ps), __float_as_uint(ps), false, false);
    ps = __uint_as_float(rr[0]) + __uint_as_float(rr[1]); }
  l_reg = l_reg * alpha + ps;
#define PK4(P, BASE, OUT) do { unsigned a0 = cvt_pk_bf16(P[BASE + 0], P[BASE + 1]), a1 = cvt_pk_bf16(P[BASE + 2], P[BASE + 3]);   \
    unsigned b0 = cvt_pk_bf16(P[BASE + 4], P[BASE + 5]), b1 = cvt_pk_bf16(P[BASE + 6], P[BASE + 7]);                              \
    auto r0 = __builtin_amdgcn_permlane32_swap(a0, b0, false, false); auto r1 = __builtin_amdgcn_permlane32_swap(a1, b1, false, false); \
    u32x4 w = {r0[0], r1[0], r0[1], r1[1]}; OUT = *reinterpret_cast<bf16x8*>(&w); } while (0)
  PK4(p0, 0, pa0); PK4(p0, 8, pa1); PK4(p1, 0, pa2); PK4(p1, 8, pa3);
#undef PK4
}
__device__ __forceinline__ void qkt(f32x16& p0, f32x16& p1, const bf16_t* Ks, const bf16x8* qr, int r32, int hi) {
  p0 = f32x16{}; p1 = f32x16{};
  for (int d0 = 0; d0 < 8; ++d0) { int cb = (d0 * 16 + hi * 8) * 2;
    bf16x8 b0 = *reinterpret_cast<const bf16x8*>((const char*)Ks + KSWZ(r32, cb));
    bf16x8 b1 = *reinterpret_cast<const bf16x8*>((const char*)Ks + KSWZ(32 + r32, cb));
    p0 = __builtin_amdgcn_mfma_f32_32x32x16_bf16(b0, qr[d0], p0, 0, 0, 0);
    p1 = __builtin_amdgcn_mfma_f32_32x32x16_bf16(b1, qr[d0], p1, 0, 0, 0); }
}
__device__ __forceinline__ int v_st(int k, int c) { const int kk = (k & ~0xC) | ((k & 4) << 1) | ((k & 8) >> 1); return ((kk >> 3) * 4 + (c >> 5)) * 512 + ((kk & 7) * 32 + (c & 31)) * 2; }
__device__ __forceinline__ int v_rd_base(int lane) { return ((lane & 3) << 3) | (((lane >> 2) & 3) << 6) | (((lane >> 4) & 1) << 5) | (((lane >> 5) & 1) << 8); }
constexpr int v_rd_off(int d0, int ks, int half) { return d0 * 512 + ks * 4096 + half * 2048; }
template <int OFF> __device__ __forceinline__ s16x4 tr_read(int vb) {
  s16x4 r; asm volatile("ds_read_b64_tr_b16 %0, %1 offset:%2" : "=&v"(r) : "v"(vb), "i"(OFF) : "memory"); return r;
}
template <int D0> __device__ __forceinline__ void pv_one(f32x16& od, int vb, bf16x8 pa0, bf16x8 pa1, bf16x8 pa2, bf16x8 pa3) {
  const s16x4 l0 = tr_read<v_rd_off(D0, 0, 0)>(vb), h0 = tr_read<v_rd_off(D0, 0, 1)>(vb), l1 = tr_read<v_rd_off(D0, 1, 0)>(vb), h1 = tr_read<v_rd_off(D0, 1, 1)>(vb);
  const s16x4 l2 = tr_read<v_rd_off(D0, 2, 0)>(vb), h2 = tr_read<v_rd_off(D0, 2, 1)>(vb), l3 = tr_read<v_rd_off(D0, 3, 0)>(vb), h3 = tr_read<v_rd_off(D0, 3, 1)>(vb);
  asm volatile("s_waitcnt lgkmcnt(0)" ::: "memory"); SBAR();
#define PK(L, H) (bf16x8){L[0], L[1], L[2], L[3], H[0], H[1], H[2], H[3]}
  od = __builtin_amdgcn_mfma_f32_32x32x16_bf16(pa0, PK(l0, h0), od, 0, 0, 0);
  od = __builtin_amdgcn_mfma_f32_32x32x16_bf16(pa1, PK(l1, h1), od, 0, 0, 0);
  od = __builtin_amdgcn_mfma_f32_32x32x16_bf16(pa2, PK(l2, h2), od, 0, 0, 0);
  od = __builtin_amdgcn_mfma_f32_32x32x16_bf16(pa3, PK(l3, h3), od, 0, 0, 0);
#undef PK
}
__device__ __forceinline__ void pv_d0(f32x16* o, int vb, bf16x8 pa0, bf16x8 pa1, bf16x8 pa2, bf16x8 pa3) {
  pv_one<0>(o[0], vb, pa0, pa1, pa2, pa3); pv_one<1>(o[1], vb, pa0, pa1, pa2, pa3); pv_one<2>(o[2], vb, pa0, pa1, pa2, pa3); pv_one<3>(o[3], vb, pa0, pa1, pa2, pa3);
}
__device__ __forceinline__ float tile_bias(f32x16& p0, f32x16& p1, const int kt, const int q0w, const int r32, const int hi, const float* tab) {
  const int k0 = kt * KVBLK;
  if (kt >= 2) { if (k0 + 63 - q0w <= -91) return tab[0]; if (k0 - (q0w + 31) >= 91) return tab[182]; }
  const int d0 = k0 + 4 * hi - (q0w + r32) + 91, m01 = kt <= 1 ? 183 : 0, m0 = kt == 0 ? 183 : 0;
#pragma unroll
  for (int r = 0; r < 16; ++r) { const int i0 = max(min(max(d0 + (r & 3) + 8 * (r >> 2), 0), 182), m01), i1 = max(min(max(d0 + 32 + (r & 3) + 8 * (r >> 2), 0), 182), r < 8 ? m01 : m0);
    p0[r] += tab[i0]; p1[r] += tab[i1]; }
  return 0.f;
}
__device__ __forceinline__ void attn_pass(const int PASS, const bf16_t* __restrict__ Qb, const bf16_t* __restrict__ Kh, const bf16_t* __restrict__ Vh, float* __restrict__ Ob, const int q0, char* lds) {
  int tid_ = threadIdx.x; asm volatile("" : "+v"(tid_));
  const int tid = tid_, wid = tid >> 6, lane = tid & 63, r32 = lane & 31, hi = lane >> 5;
  bf16_t* V_lds = (bf16_t*)lds; bf16_t* K_lds = (bf16_t*)(lds + 2 * SHM_V);
  float* ws = (float*)(lds + 2 * SHM_V + 2 * SHM_K) + wid * 64; float* li_l = ws; float* al_l = ws + 32;
  const float* tab = (const float*)(lds + TAB_B);
  const int q0w = q0 + wid * QBLK;
  float m_reg = -1e30f, l_reg = 0; f32x16 o[4] = {}; bf16x8 qr[8];
  const bf16_t* Qw = Qb + (long)(wid * QBLK + r32) * LDQ + hi * 8;
#pragma unroll
  for (int d0 = 0; d0 < 8; ++d0) qr[d0] = *reinterpret_cast<const bf16x8*>(Qw + d0 * 16);
  const int sr = tid >> 4, sc = (tid & 15) * 8, vst0 = v_st(sr, sc), vst1 = v_st(32 + sr, sc);
  const int vb0 = (int)(uintptr_t)V_lds + v_rd_base(lane);
  const unsigned loff = (unsigned)(sr * LDK + sc) * 2u;
  struct { bf16x8 vs0, vs1, ks0, ks1; } sr_[1];
#define SLOAD(i, k0) do { const char* vb_ = (const char*)Vh + (size_t)(k0) * (LDK * 2); const char* kb_ = (const char*)Kh + (size_t)(k0) * (LDK * 2); \
    sr_[i].vs0 = *reinterpret_cast<const bf16x8*>(vb_ + loff); sr_[i].vs1 = *reinterpret_cast<const bf16x8*>(vb_ + 32 * LDK * 2 + loff); \
    sr_[i].ks0 = *reinterpret_cast<const bf16x8*>(kb_ + loff); sr_[i].ks1 = *reinterpret_cast<const bf16x8*>(kb_ + 32 * LDK * 2 + loff); } while (0)
#define SWRITE(b, i) do { *(bf16x8*)((char*)V_lds + (b) * SHM_V + vst0) = sr_[i].vs0;          \
    *(bf16x8*)((char*)V_lds + (b) * SHM_V + vst1) = sr_[i].vs1; int kc = sc * 2;               \
    *(bf16x8*)((char*)K_lds + (b) * SHM_K + KSWZ(sr, kc)) = sr_[i].ks0;                       \
    *(bf16x8*)((char*)K_lds + (b) * SHM_K + KSWZ(32 + sr, kc)) = sr_[i].ks1; } while (0)
#define SWAIT() asm volatile("s_waitcnt vmcnt(0)" ::: "memory")
#define RESC(a) do { if (__any((a) < 1.f)) { if (hi == 0) al_l[r32] = (a); asm volatile("s_waitcnt lgkmcnt(0)" ::: "memory"); \
    for (int d = 0; d < 4; ++d) for (int r = 0; r < 16; ++r) o[d][r] *= al_l[crow(r, hi)]; } } while (0)
  f32x16 pA0, pA1, pB0, pB1; float mnA, mnB, alA, alB; bf16x8 pa0, pa1, pa2, pa3; int NT = LP / KVBLK; asm volatile("" : "+s"(NT));
  constexpr int SE = 0, SO = 0;
  SLOAD(SE, 0); asm volatile("s_waitcnt vmcnt(0)" ::: "memory"); SWRITE(0, SE); __syncthreads();
  qkt(pA0, pA1, K_lds, qr, r32, hi); { const float ca = tile_bias(pA0, pA1, 0, q0w, r32, hi, tab); partialSM(pA0, pA1, m_reg, mnA, alA, ca); }
  SLOAD(SO, KVBLK);
  SWAIT(); SWRITE(1, SO); __syncthreads();
  for (int j = 1; j + 1 < NT; j += 2) {
    SBAR(); qkt(pB0, pB1, (bf16_t*)((char*)K_lds + SHM_K), qr, r32, hi);
    finishSM(pA0, pA1, alA, l_reg, pa0, pa1, pa2, pa3); SBAR();
    SLOAD(SO, (j + 1) * KVBLK); SBAR();
    pv_d0(o, vb0, pa0, pa1, pa2, pa3); { const float cb = tile_bias(pB0, pB1, j, q0w, r32, hi, tab); partialSM(pB0, pB1, m_reg, mnB, alB, cb); }
    __syncthreads(); SWAIT(); SWRITE(0, SE);
    RESC(alB); __syncthreads();
    SBAR(); qkt(pA0, pA1, K_lds, qr, r32, hi);
    finishSM(pB0, pB1, alB, l_reg, pa0, pa1, pa2, pa3); SBAR();
    SLOAD(SE, (j + 2) * KVBLK); SBAR();
    pv_d0(o, vb0 + (int)SHM_V, pa0, pa1, pa2, pa3); { const float ca = tile_bias(pA0, pA1, j + 1, q0w, r32, hi, tab); partialSM(pA0, pA1, m_reg, mnA, alA, ca); }
    __syncthreads(); SWAIT(); SWRITE(1, SO);
    RESC(alA); __syncthreads();
  }
  SBAR(); qkt(pB0, pB1, (bf16_t*)((char*)K_lds + SHM_K), qr, r32, hi);
  finishSM(pA0, pA1, alA, l_reg, pa0, pa1, pa2, pa3); SBAR();
  pv_d0(o, vb0, pa0, pa1, pa2, pa3); { const float cb = tile_bias(pB0, pB1, NT - 1, q0w, r32, hi, tab); partialSM(pB0, pB1, m_reg, mnB, alB, cb); }
  __syncthreads(); RESC(alB);
  finishSM(pB0, pB1, alB, l_reg, pa0, pa1, pa2, pa3); SBAR();
  pv_d0(o, vb0 + (int)SHM_V, pa0, pa1, pa2, pa3);
  if (hi == 0) li_l[r32] = l_reg; asm volatile("s_waitcnt lgkmcnt(0)" ::: "memory");
  float rli[16];
#pragma unroll
  for (int r = 0; r < 16; ++r) rli[r] = __builtin_amdgcn_rcpf(li_l[crow(r, hi)]);
  const float lam = tab[184];
  float* Ow = Ob + (long)(wid * QBLK) * 1024 + r32;
  { const float osc = PASS ? lam : 1.0f;
#pragma unroll
    for (int r = 0; r < 16; ++r) { const int orow = crow(r, hi); const float f = rli[r] * osc;
#pragma unroll
      for (int d0 = 0; d0 < 4; ++d0) Ow[(long)orow * 1024 + d0 * 32] = o[d0][r] * f; } }
  __syncthreads();
#undef SLOAD
#undef SWRITE
#undef SWAIT
#undef RESC
}
#undef KSWZ
#undef SBAR
}
__device__ __forceinline__ void phase_attn(const Params& p, unsigned char* lds_) {
    char* lds = (char*)lds_; float* tab = (float*)(lds + att::TAB_B);
    const int tid = otid();
    for (int it = blockIdx.x; it < 256; it += gridDim.x) {
        const int g = (it & 7) * 2 + ((it >> 3) >> 4), qb = (it >> 3) & 15, b = g >> 3, h = (g >> 1) & 3, dvh = g & 1;
        if (tid < 183) tab[tid] = p.rel_bias[t5_bucket(tid - 91) * 4 + h] * (1.0f / att::SCALE); else if (tid == 183) tab[183] = -1e30f;
        if (tid >= 448) { const int l = tid - 448; float a = p.lamp[l] * p.lamp[128 + l] + p.lamp[64 + l] * p.lamp[192 + l], c = p.lamp[256 + l] * p.lamp[384 + l] + p.lamp[320 + l] * p.lamp[448 + l];
            a = wave_sum(a); c = wave_sum(c); if (l == 0) tab[184] = __expf(a) - __expf(c) + 0.2f; }
        __syncthreads();
        const int q0 = PADF + NMETA + qb * 256;
        const bf16_t* Pb = p.P() + (size_t)b * LP * NPROJ;
        const size_t ooff = (size_t)(b * SEQ + qb * 256) * 1024 + h * 256 + dvh * 128;
#pragma unroll 1
        for (int pass = 0; pass < 2; ++pass)
            att::attn_pass(pass, Pb + (size_t)q0 * NPROJ + h * 256 + pass * 128, Pb + 1024 + h * 256 + pass * 128, Pb + 2048 + h * 256 + dvh * 128, (pass ? p.HS() : p.OS()) + ooff, q0, lds);
    }
}
__device__ __forceinline__ void phase_yda(const Params& p) {
    const int tid = otid(), wid = tid >> 6, lane = tid & 63;
    const float4 g = *(const float4*)(p.subln + lane * 4);
    static_assert((NTOK * 4) % (NWG * 8 * 4) == 0, "yda batches");
    for (int w0 = blockIdx.x * 8 + wid; w0 < NTOK * 4; w0 += gridDim.x * 8 * 4) {
        float4 v[4];
#pragma unroll
        for (int q = 0; q < 4; ++q) { const size_t o_ = (size_t)(w0 + q * gridDim.x * 8) * 256 + lane * 4; const float4 a = *(const float4*)(p.OS() + o_), c = *(const float4*)(p.HS() + o_); v[q] = make_float4(a.x - c.x, a.y - c.y, a.z - c.z, a.w - c.w); }
#pragma unroll
        for (int q = 0; q < 4; ++q) { const int w = w0 + q * gridDim.x * 8;
            const float ss = wave_sum(v[q].x * v[q].x + v[q].y * v[q].y + v[q].z * v[q].z + v[q].w * v[q].w); const float rs = rsqrtf(ss / 256.f + EPS) * 0.8f;
            u32x2 o; o.x = cvt_pk_bf16(v[q].x * rs * g.x, v[q].y * rs * g.y); o.y = cvt_pk_bf16(v[q].z * rs * g.z, v[q].w * rs * g.w);
            *(u32x2*)(p.YDM() + (size_t)w * 256 + lane * 4) = o; }
    }
}


namespace mls {
using att::f32x16; using att::s16x4; using att::crow; using att::v_st; using att::v_rd_base; using att::v_rd_off; using att::tr_read; using att::pv_d0;
constexpr int NCH = 33;
__device__ __forceinline__ bf16x8 scale8(bf16x8 v, float w) { const u32x4 u = *reinterpret_cast<u32x4*>(&v); u32x4 o;
    o.x = cvt_pk_bf16(bflo(u.x) * w, bfhi(u.x) * w); o.y = cvt_pk_bf16(bflo(u.y) * w, bfhi(u.y) * w); o.z = cvt_pk_bf16(bflo(u.z) * w, bfhi(u.z) * w); o.w = cvt_pk_bf16(bflo(u.w) * w, bfhi(u.w) * w);
    return *reinterpret_cast<bf16x8*>(&o); }
template <int NCT, bool SCALE>
__device__ __forceinline__ void stage_img(const bf16_t* src, const int ld, char* img, const float* wrow, const int tid) {
    const int sr = tid >> 4, sc = (tid & 15) * 8, o0 = v_st(sr, sc), o1 = v_st(32 + sr, sc);
#pragma unroll
    for (int ct = 0; ct < NCT; ++ct)
#pragma unroll
        for (int rt = 0; rt < 2; ++rt) { const bf16_t* s0 = src + (size_t)(rt * 64 + sr) * ld + ct * 128 + sc;
            bf16x8 v0 = *reinterpret_cast<const bf16x8*>(s0), v1 = *reinterpret_cast<const bf16x8*>(s0 + (size_t)32 * ld);
            if (SCALE) { v0 = scale8(v0, wrow[rt * 64 + sr]); v1 = scale8(v1, wrow[rt * 64 + 32 + sr]); }
            *reinterpret_cast<bf16x8*>(img + (ct * 2 + rt) * 16384 + o0) = v0; *reinterpret_cast<bf16x8*>(img + (ct * 2 + rt) * 16384 + o1) = v1; }
}
__device__ __forceinline__ void m0_conv_gates(const Params& p) {
    const int tid = otid(), wid = tid >> 6, lane = tid & 63;
    const bf16_t* P = p.P(); bf16_t* Qc = p.Qc(); bf16_t* Kc = p.Kc();
    {
        const int c8 = (tid & 127) * 8; const float sc = c8 < 512 ? 0.08838834764831845f : 1.0f;
        float4 w0[5], w1[5];
#pragma unroll
        for (int j = 0; j < 5; ++j) { w0[j] = *(const float4*)(p.conv_w + j * 1024 + c8); w1[j] = *(const float4*)(p.conv_w + j * 1024 + c8 + 4); }
        const int stride = gridDim.x * 512;
        for (int idx0 = blockIdx.x * 512 + tid; idx0 < R * 128; idx0 += 2 * stride) {
            u32x4 u[2][5];
#pragma unroll
            for (int q = 0; q < 2; ++q) { const int idx = idx0 + q * stride, r = idx >> 7, pp = r % LP;
#pragma unroll
                for (int j = 0; j < 5; ++j) { const int rr = r + j - 2, pin = pp + j - 2; u[q][j] = (u32x4){0u, 0u, 0u, 0u};
                    if (idx < R * 128 && pp >= PADF && pin >= PADF && pin < LP) u[q][j] = *(const u32x4*)(P + (size_t)rr * NPROJ + C_MQ + c8); } }
#pragma unroll
            for (int q = 0; q < 2; ++q) { const int idx = idx0 + q * stride, r = idx >> 7; if (idx >= R * 128) break;
                float acc[8];
#pragma unroll
                for (int j = 0; j < 8; ++j) acc[j] = 0.f;
#pragma unroll
                for (int j = 0; j < 5; ++j) { const u32x4 t = u[q][j];
                    acc[0] += w0[j].x * bflo(t.x); acc[1] += w0[j].y * bfhi(t.x); acc[2] += w0[j].z * bflo(t.y); acc[3] += w0[j].w * bfhi(t.y);
                    acc[4] += w1[j].x * bflo(t.z); acc[5] += w1[j].y * bfhi(t.z); acc[6] += w1[j].z * bflo(t.w); acc[7] += w1[j].w * bfhi(t.w); }
#pragma unroll
                for (int j = 0; j < 8; ++j) acc[j] = acc[j] * __builtin_amdgcn_rcpf(1.0f + __expf(-acc[j])) * sc;
                u32x4 o; o.x = cvt_pk_bf16(acc[0], acc[1]); o.y = cvt_pk_bf16(acc[2], acc[3]); o.z = cvt_pk_bf16(acc[4], acc[5]); o.w = cvt_pk_bf16(acc[6], acc[7]);
                if (c8 < 512) *(u32x4*)(Qc + (size_t)r * 512 + c8) = o; else *(u32x4*)(Kc + (size_t)r * 512 + (c8 - 512)) = o; }
        }
    }
    for (int task = blockIdx.x * 8 + wid; task < 16 * NCH; task += gridDim.x * 8) {
        const int seq = task / NCH, c = task % NCH, b = seq >> 3, h = (seq >> 1) & 3, dir = seq & 1;
        const float bi = p.gate_bias[(dir * 2) * 4 + h], bfb = p.gate_bias[(dir * 2 + 1) * 4 + h];
        float li[2], lf[2]; int tt[2];
#pragma unroll
        for (int q = 0; q < 2; ++q) { const int i = 2 * lane + q, t = dir ? 127 - i : i, pp = c * 128 + t; tt[q] = t;
            if (pp >= PADF) { const float* g = p.gates() + (size_t)(b * LP + pp) * 16; li[q] = g[(dir * 2) * 4 + h] + bi; lf[q] = logsigmoidf_(g[(dir * 2 + 1) * 4 + h] + bfb); }
            else { li[q] = -__builtin_inff(); lf[q] = 0.f; } }
        float s1 = lf[0] + lf[1], incl = s1;
#pragma unroll
        for (int o = 1; o < 64; o <<= 1) { const float t = __shfl_up(incl, o); if (lane >= o) incl += t; }
        const float b1 = incl, b0 = incl - lf[1];
        const float a0 = li[0] - b0, a1 = li[1] - b1;
        float pm = fmaxf(a0, a1), run = pm;
#pragma unroll
        for (int o = 1; o < 64; o <<= 1) { const float t = __shfl_up(run, o); if (lane >= o) run = fmaxf(run, t); }
        const float excl = __shfl_up(run, 1); const float pm0 = lane ? fmaxf(excl, a0) : a0, pm1 = run;
        float* GB = p.GB() + (size_t)seq * LP + c * 128; float* GA = p.GA() + (size_t)seq * LP + c * 128; float* GPM = p.GPM() + (size_t)seq * LP + c * 128;
        GB[tt[0]] = b0; GB[tt[1]] = b1; GA[tt[0]] = a0; GA[tt[1]] = a1; GPM[tt[0]] = pm0; GPM[tt[1]] = pm1;
        const float Atot = __shfl(run, 63), Btot = __shfl(incl, 63);
        if (lane == 0) { p.CS()[(seq * NCH + c) * 2] = Atot; p.CS()[(seq * NCH + c) * 2 + 1] = Btot; }
    }
}
__device__ __forceinline__ void m1_summaries(const Params& p, unsigned char* lds_) {
    char* lds = (char*)lds_; char* Vimg = lds; char* Kimg = lds + 65536; float* wrow = (float*)(lds + 98304);
    for (int it = blockIdx.x; it < 512; it += gridDim.x) {
        int tid_ = threadIdx.x; asm volatile("" : "+v"(tid_)); const int tid = tid_, wid = tid >> 6, lane = tid & 63, r32 = lane & 31, hi = lane >> 5;
        const int seq = it >> 5, k = it & 31, b = seq >> 3, h = (seq >> 1) & 3, dir = seq & 1, c = dir ? 32 - k : k;
        const int r0 = b * LP + c * 128;
        if (tid < 128) wrow[tid] = __expf(p.GA()[(size_t)seq * LP + c * 128 + tid] - p.CS()[(seq * NCH + c) * 2]);
        __syncthreads();
        stage_img<1, false>(p.Kc() + (size_t)r0 * 512 + h * 128, 512, Kimg, nullptr, tid);
        stage_img<2, true>(p.P() + (size_t)r0 * NPROJ + C_MV + h * 256, NPROJ, Vimg, wrow, tid);
        if (tid < 128) { float s = 0.f; const bf16_t* kp = p.Kc() + (size_t)r0 * 512 + h * 128 + tid; for (int q = 0; q < 128; ++q) s += wrow[q] * bf2f(kp[(size_t)q * 512]); p.DN()[((size_t)seq * NCH + c) * 128 + tid] = s; }
        __syncthreads();
        const int dkb = wid & 3, dvh = wid >> 2;
        f32x16 o[4] = {};
        const int vbV = (int)(uintptr_t)Vimg + v_rd_base(lane) + dvh * 32768, vbK = (int)(uintptr_t)Kimg + v_rd_base(lane) + dkb * 512;
#pragma unroll
        for (int rt = 0; rt < 2; ++rt) {
            const int kb = vbK + rt * 16384;
            const s16x4 l0 = tr_read<v_rd_off(0, 0, 0)>(kb), h0 = tr_read<v_rd_off(0, 0, 1)>(kb), l1 = tr_read<v_rd_off(0, 1, 0)>(kb), h1 = tr_read<v_rd_off(0, 1, 1)>(kb);
            const s16x4 l2 = tr_read<v_rd_off(0, 2, 0)>(kb), h2 = tr_read<v_rd_off(0, 2, 1)>(kb), l3 = tr_read<v_rd_off(0, 3, 0)>(kb), h3 = tr_read<v_rd_off(0, 3, 1)>(kb);
            asm volatile("s_waitcnt lgkmcnt(0)" ::: "memory"); __builtin_amdgcn_sched_barrier(0);
#define PK(L, H) (bf16x8){L[0], L[1], L[2], L[3], H[0], H[1], H[2], H[3]}
            pv_d0(o, vbV + rt * 16384, PK(l0, h0), PK(l1, h1), PK(l2, h2), PK(l3, h3));
#undef PK
        }
        float* dc = p.DC() + ((size_t)seq * NCH + c) * 32768;
#pragma unroll
        for (int r = 0; r < 16; ++r) { const int dk = dkb * 32 + crow(r, hi);
#pragma unroll
            for (int d0 = 0; d0 < 4; ++d0) dc[(size_t)dk * 256 + dvh * 128 + d0 * 32 + r32] = o[d0][r]; }
        __syncthreads();
    }
}
__device__ __forceinline__ void m2_scan(const Params& p) {
    const int gid = blockIdx.x * 512 + otid();
    for (int g = gid; g < 16 * 128 * 64; g += gridDim.x * 512) {
        const int seq = g >> 13, rem = g & 8191, dk = rem >> 6, dv4 = (rem & 63) * 4, dir = seq & 1;
        float4 C = make_float4(0.f, 0.f, 0.f, 0.f); float n = 0.f, m = 0.f;
        for (int k0 = 0; k0 < NCH; k0 += 8) {
            float4 d[8]; float dn[8];
#pragma unroll
            for (int j = 0; j < 8; ++j) { const int k = k0 + j; if (k < NCH - 1) { const int c = dir ? 32 - k : k; const size_t sc = (size_t)seq * NCH + c;
                d[j] = *(const float4*)(p.DC() + sc * 32768 + (size_t)dk * 256 + dv4); dn[j] = dv4 == 0 ? p.DN()[sc * 128 + dk] : 0.f; } else { d[j] = make_float4(0.f, 0.f, 0.f, 0.f); dn[j] = 0.f; } }
#pragma unroll
            for (int j = 0; j < 8; ++j) { const int k = k0 + j; if (k < NCH) { const int c = dir ? 32 - k : k; const size_t sc = (size_t)seq * NCH + c;
                u32x2 w; w.x = cvt_pk_bf16(C.x, C.y); w.y = cvt_pk_bf16(C.z, C.w); *(u32x2*)(p.Cst() + sc * 32768 + (size_t)dk * 256 + dv4) = w;
                if (dv4 == 0) p.Nst()[sc * 128 + dk] = n; if (rem == 0) p.Mst()[sc] = m;
                if (k < NCH - 1) { const float A = p.CS()[sc * 2], B = p.CS()[sc * 2 + 1], Mx = fmaxf(m, A), wc = __expf(m - Mx), ws = __expf(A - Mx);
                    C.x = wc * C.x + ws * d[j].x; C.y = wc * C.y + ws * d[j].y; C.z = wc * C.z + ws * d[j].z; C.w = wc * C.w + ws * d[j].w;
                    n = wc * n + ws * dn[j]; m = B + Mx; } } }
        }
    }
}
#define KSWZ(row, colB) ((row) * 256 + ((colB) ^ (((row) & 7) << 4)))
__device__ __forceinline__ void m3_outputs(const Params& p, unsigned char* lds_) {
    char* lds = (char*)lds_; char* Vimg = lds; char* Cimg = lds + 65536; char* Kt = lds + 65536;
    float* tabA = (float*)(lds + 131072);
    float* tabN = tabA + 256;
    float* wsc = tabN + 128;
    for (int it = blockIdx.x; it < 256; it += gridDim.x) {
        int tid_ = threadIdx.x; asm volatile("" : "+v"(tid_)); const int tid = tid_, wid = tid >> 6, lane = tid & 63, r32 = lane & 31, hi = lane >> 5;
        float* ws = wsc + wid * 64;
        const int c = 1 + (it & 31), bh = it >> 5, b = bh >> 2, h = bh & 3, r0 = b * LP + c * 128, tt = wid & 3, dvh = wid >> 2, t = tt * 32 + r32;
        { const int sr = tid >> 4, sc = (tid & 15) * 8;
#pragma unroll
          for (int rt = 0; rt < 2; ++rt) { const bf16_t* s0 = p.Kc() + (size_t)(r0 + rt * 64 + sr) * 512 + h * 128 + sc;
              *reinterpret_cast<bf16x8*>(Kt + rt * 16384 + KSWZ(sr, sc * 2)) = *reinterpret_cast<const bf16x8*>(s0);
              *reinterpret_cast<bf16x8*>(Kt + rt * 16384 + KSWZ(32 + sr, sc * 2)) = *reinterpret_cast<const bf16x8*>(s0 + 32 * 512); } }
        stage_img<2, false>(p.P() + (size_t)r0 * NPROJ + C_MV + h * 256, NPROJ, Vimg, nullptr, tid);
        if (tid < 256) { const int dir = tid >> 7, s = tid & 127; tabA[tid] = p.GA()[(size_t)((b * 4 + h) * 2 + dir) * LP + c * 128 + s]; }
        bf16x8 qr[8];
        { const bf16_t* Qw = p.Qc() + (size_t)(r0 + t) * 512 + h * 128 + hi * 8;
#pragma unroll
          for (int d0 = 0; d0 < 8; ++d0) qr[d0] = *reinterpret_cast<const bf16x8*>(Qw + d0 * 16); }
        __syncthreads();
        f32x16 s0a, s0b, s1a, s1b;
        att::qkt(s0a, s0b, (const bf16_t*)Kt, qr, r32, hi); att::qkt(s1a, s1b, (const bf16_t*)(Kt + 16384), qr, r32, hi);
        __syncthreads();
        const unsigned pfo = *(const __attribute__((address_space(1))) unsigned char*)((const __attribute__((address_space(1))) char*)p.P()
            + ((size_t)(tok2prow(b * SEQ + (c - 1) * 128 + tt * 32) + (lane >> 1)) * NPROJ + C_MO + h * 256 + dvh * 128) * 2 + (lane & 1) * 128);
#pragma unroll 1
        for (int dir = 0; dir < 2; ++dir) {
            const int seq = (b * 4 + h) * 2 + dir; const size_t sc = (size_t)seq * NCH + c;
            stage_img<2, false>(p.Cst() + sc * 32768, 256, Cimg, nullptr, tid);
            if (tid < 128) tabN[tid] = p.Nst()[sc * 128 + tid];
            const float mc = p.Mst()[sc], pmt = p.GPM()[(size_t)seq * LP + c * 128 + t], bt = p.GB()[(size_t)seq * LP + c * 128 + t];
            const float Mt = fmaxf(mc, pmt), winter = __expf(mc - Mt), einv = __expf(-(bt + Mt));
            __syncthreads();
            int t_o = t, hi_o = hi; asm volatile("" : "+v"(t_o), "+v"(hi_o));
            const float* ta = tabA + dir * 128 + 4 * hi_o; const int tq = t_o - 4 * hi_o;
            float qn = 0.f;
#pragma unroll
            for (int d0 = 0; d0 < 8; ++d0) { const u32x4 u = *reinterpret_cast<const u32x4*>(&qr[d0]); const float* nn = tabN + d0 * 16 + hi * 8;
                qn += bflo(u.x) * nn[0] + bfhi(u.x) * nn[1] + bflo(u.y) * nn[2] + bfhi(u.y) * nn[3] + bflo(u.z) * nn[4] + bfhi(u.z) * nn[5] + bflo(u.w) * nn[6] + bfhi(u.w) * nn[7]; }
            { auto rr = __builtin_amdgcn_permlane32_swap(__float_as_uint(qn), __float_as_uint(qn), false, false); qn = __uint_as_float(rr[0]) + __uint_as_float(rr[1]); }
            if (hi == 0) ws[r32] = winter;
            f32x16 o[4] = {};
            const int vbC = (int)(uintptr_t)Cimg + v_rd_base(lane) + dvh * 32768, vbV = (int)(uintptr_t)Vimg + v_rd_base(lane) + dvh * 32768;
            pv_d0(o, vbC, qr[0], qr[1], qr[2], qr[3]); pv_d0(o, vbC + 16384, qr[4], qr[5], qr[6], qr[7]);
            asm volatile("s_waitcnt lgkmcnt(0)" ::: "memory");
#pragma unroll
            for (int r = 0; r < 16; ++r) { const float wi = ws[crow(r, hi)];
#pragma unroll
                for (int d0 = 0; d0 < 4; ++d0) o[d0][r] *= wi; }
            __builtin_amdgcn_sched_barrier(0);
            float rs = 0.f; bf16x8 sa0, sa1, sa2, sa3;
#define WGT(SV, KB, OUT0, OUT1) do { float e[16]; _Pragma("unroll") for (int r = 0; r < 16; ++r) { const int s4 = (KB) + (r & 3) + 8 * (r >> 2); const int d = dir ? s4 - tq : tq - s4; \
                const float w = __expf(ta[s4] - Mt + (float)min(d, 0) * 1e30f); e[r] = SV[r] * w; rs += e[r]; } \
                { unsigned a0 = cvt_pk_bf16(e[0], e[1]), a1 = cvt_pk_bf16(e[2], e[3]), b0 = cvt_pk_bf16(e[4], e[5]), b1 = cvt_pk_bf16(e[6], e[7]); \
                  auto x0 = __builtin_amdgcn_permlane32_swap(a0, b0, false, false); auto x1 = __builtin_amdgcn_permlane32_swap(a1, b1, false, false); u32x4 w4 = {x0[0], x1[0], x0[1], x1[1]}; OUT0 = *reinterpret_cast<bf16x8*>(&w4); } \
                { unsigned a0 = cvt_pk_bf16(e[8], e[9]), a1 = cvt_pk_bf16(e[10], e[11]), b0 = cvt_pk_bf16(e[12], e[13]), b1 = cvt_pk_bf16(e[14], e[15]); \
                  auto x0 = __builtin_amdgcn_permlane32_swap(a0, b0, false, false); auto x1 = __builtin_amdgcn_permlane32_swap(a1, b1, false, false); u32x4 w4 = {x0[0], x1[0], x0[1], x1[1]}; OUT1 = *reinterpret_cast<bf16x8*>(&w4); } } while (0)
            WGT(s0a, 0, sa0, sa1); __builtin_amdgcn_sched_barrier(0); WGT(s0b, 32, sa2, sa3); __builtin_amdgcn_sched_barrier(0);
            pv_d0(o, vbV, sa0, sa1, sa2, sa3); __builtin_amdgcn_sched_barrier(0);
            WGT(s1a, 64, sa0, sa1); __builtin_amdgcn_sched_barrier(0); WGT(s1b, 96, sa2, sa3); __builtin_amdgcn_sched_barrier(0);
            pv_d0(o, vbV + 16384, sa0, sa1, sa2, sa3);
#undef WGT
            { auto rr = __builtin_amdgcn_permlane32_swap(__float_as_uint(rs), __float_as_uint(rs), false, false); rs = __uint_as_float(rr[0]) + __uint_as_float(rr[1]); }
            const float den = winter * qn + rs; const float hscale = __builtin_amdgcn_rcpf(fmaxf(fabsf(den), einv));
            if (hi == 0) ws[32 + r32] = hscale;
            asm volatile("s_waitcnt lgkmcnt(0)" ::: "memory");
            int r32o = r32, hi_e = hi; asm volatile("" : "+v"(r32o), "+v"(hi_e));
            const unsigned tok0 = (unsigned)(b * SEQ + (c - 1) * 128 + tt * 32), colo = (unsigned)(h * 256 + dvh * 128 + r32o);
            if (dir == 0) {
#pragma unroll
                for (int r = 0; r < 16; ++r) { const float hs_ = ws[32 + crow(r, hi_e)]; float* hp = (float*)((char*)p.HS() + ((tok0 + crow(r, hi_e)) * 1024u + colo) * 4u);
#pragma unroll
                    for (int d0 = 0; d0 < 4; ++d0) hp[d0 * 32] = o[d0][r] * hs_; }
            } else {
                asm volatile("" :: "v"(pfo));
                const unsigned prow0 = (unsigned)tok2prow((int)tok0);
#pragma unroll
                for (int r = 0; r < 16; ++r) { const float hs_ = ws[32 + crow(r, hi_e)]; const unsigned tok = tok0 + crow(r, hi_e);
                    const float* hp = (const float*)((const char*)p.HS() + (tok * 1024u + colo) * 4u); const bf16_t* op = (const bf16_t*)((const char*)p.P() + ((prow0 + crow(r, hi_e)) * (unsigned)NPROJ + C_MO + colo) * 2u);
                    bf16_t* yp = (bf16_t*)((char*)p.YDM() + (((unsigned)NTOK + tok) * 1024u + colo) * 2u);
#pragma unroll
                    for (int d0 = 0; d0 < 4; ++d0) { const float hv = hp[d0 * 32] + o[d0][r] * hs_; const float g = __builtin_amdgcn_rcpf(1.0f + __expf(-bf2f(op[d0 * 32])));
                        yp[d0 * 32] = (bf16_t)(cvt_pk_bf16(g * hv, 0.f) & 0xffffu); }
                    asm volatile("" ::: "memory"); }
            }
            __syncthreads();
        }
    }
}
#undef KSWZ
}

struct SchedBranch { static constexpr bool BTILED = false; static constexpr bool GATHER = false; pg8::TileOrder T;
    __device__ bool next(int i, pg8::Unit& u) const { int pm, pn; if (!T.tile(i >> 1, pm, pn)) return false; const int which = 1 - (i & 1);
        u.a0 = which * NTOK + pm * 256; u.b0 = which * 2048 + pn * 256; u.r0 = pm * 256; u.c0 = pn * 256; u.aux = which; u.nv = 256; u.rot = 0; return true; }
    __device__ int arow(const pg8::Unit&, int) const { return 0; } };
struct EpiBranch { static constexpr bool PERM = true; bf16_t* MIX; const bf16_t* P;
    __device__ __forceinline__ pg8::PF prefetch(const pg8::Unit& u, int tid) const { unsigned v[4];
#pragma unroll
        for (int j = 0; j < 4; ++j) { const int L = j * 512 + tid, row = L >> 3, seg = L & 7; v[j] = *(const __attribute__((address_space(1))) unsigned char*)((const __attribute__((address_space(1))) char*)P + ((size_t)tok2prow(u.r0 + row) * NPROJ + 6144 + u.c0 + (seg >> 2) * 2048) * 2 + (seg & 3) * 128); }
        return pg8::PF{v[0], v[1], v[2], v[3]}; }
    __device__ __forceinline__ bool keep(const pg8::Unit& u) const { return u.aux == 1; }
    __device__ __forceinline__ void operator()(f32x4 (&acc)[2][2][4][2], const pg8::Unit& u, int wr, int wc, int fr, int fq) const {
        const int col0 = u.c0 + wc * 32 + 8 * fq; const int which = u.aux;
#pragma unroll
        for (int ai = 0; ai < 2; ++ai)
#pragma unroll
            for (int m2 = 0; m2 < 4; m2 += 2) { u32x4 g0r[2][2], g1r[2][2];
#pragma unroll
                for (int q = 0; q < 2; ++q) { const int tok = u.r0 + ai * 128 + wr * 64 + (m2 + q) * 16 + fr; const bf16_t* gp = P + (size_t)tok2prow(tok) * NPROJ + 6144 + col0;
#pragma unroll
                    for (int bj = 0; bj < 2; ++bj) { g0r[q][bj] = *(const u32x4*)(gp + bj * 128); if (which == 1) g1r[q][bj] = *(const u32x4*)(gp + 2048 + bj * 128); } }
#pragma unroll
                for (int q = 0; q < 2; ++q) { const int m = m2 + q; const int tok = u.r0 + ai * 128 + wr * 64 + m * 16 + fr;
#pragma unroll
                    for (int bj = 0; bj < 2; ++bj) { const u32x4 g0 = g0r[q][bj];
                        f32x4 v0 = acc[ai][bj][m][0], v1 = acc[ai][bj][m][1];
                        if (which == 1) { const u32x4 g1 = g1r[q][bj];
                            v0[0] *= bflo(g1.x) * __builtin_amdgcn_rcpf(bflo(g0.x)); v0[1] *= bfhi(g1.x) * __builtin_amdgcn_rcpf(bfhi(g0.x)); v0[2] *= bflo(g1.y) * __builtin_amdgcn_rcpf(bflo(g0.y)); v0[3] *= bfhi(g1.y) * __builtin_amdgcn_rcpf(bfhi(g0.y));
                            v1[0] *= bflo(g1.z) * __builtin_amdgcn_rcpf(bflo(g0.z)); v1[1] *= bfhi(g1.z) * __builtin_amdgcn_rcpf(bfhi(g0.z)); v1[2] *= bflo(g1.w) * __builtin_amdgcn_rcpf(bflo(g0.w)); v1[3] *= bfhi(g1.w) * __builtin_amdgcn_rcpf(bfhi(g0.w));
                            acc[ai][bj][m][0] = v0; acc[ai][bj][m][1] = v1;
                        } else {
                            v0[0] *= bflo(g0.x); v0[1] *= bfhi(g0.x); v0[2] *= bflo(g0.y); v0[3] *= bfhi(g0.y); v1[0] *= bflo(g0.z); v1[1] *= bfhi(g0.z); v1[2] *= bflo(g0.w); v1[3] *= bfhi(g0.w);
                            u32x4 w; w.x = cvt_pk_bf16(v0[0], v0[1]); w.y = cvt_pk_bf16(v0[2], v0[3]); w.z = cvt_pk_bf16(v1[0], v1[1]); w.w = cvt_pk_bf16(v1[2], v1[3]);
                            *(u32x4*)(MIX + (size_t)tok * D + col0 + bj * 128) = w; } } } }
    }
};
struct SchedOut { static constexpr bool BTILED = false; static constexpr bool GATHER = false; pg8::TileOrder T;
    __device__ bool next(int i, pg8::Unit& u) const { int pm, pn; if (!T.tile(i, pm, pn)) return false; u.a0 = pm * 256; u.b0 = pn * 256; u.r0 = pm * 256; u.c0 = pn * 256; u.aux = 0; u.nv = 256; u.rot = 0; return true; }
    __device__ int arow(const pg8::Unit&, int) const { return 0; } };
struct EpiOut { __device__ __forceinline__ bool keep(const pg8::Unit&) const { return false; } static constexpr bool PERM = true; const float* x; bf16_t* H1;
    __device__ __forceinline__ pg8::PF prefetch(const pg8::Unit& u, int tid) const { unsigned v[4];
#pragma unroll
        for (int j = 0; j < 4; ++j) { const int L = j * 512 + tid, row = L >> 3, seg = L & 7; v[j] = *(const __attribute__((address_space(1))) unsigned char*)((const __attribute__((address_space(1))) char*)x + ((size_t)(u.r0 + row) * D + u.c0) * 4 + seg * 128); }
        return pg8::PF{v[0], v[1], v[2], v[3]}; }
    __device__ __forceinline__ void operator()(f32x4 (&acc)[2][2][4][2], const pg8::Unit& u, int wr, int wc, int fr, int fq) const {
        const int row0 = u.r0 + wr * 64 + fr, col0 = u.c0 + wc * 32 + 8 * fq;
#pragma unroll
        for (int ai = 0; ai < 2; ++ai)
#pragma unroll
            for (int m2 = 0; m2 < 4; m2 += 2) { f32x4 xr[2][2][2];
#pragma unroll
                for (int q = 0; q < 2; ++q) { const size_t o = (size_t)(row0 + ai * 128 + (m2 + q) * 16) * D + col0;
#pragma unroll
                    for (int bj = 0; bj < 2; ++bj) { xr[q][bj][0] = *(const f32x4*)(x + o + bj * 128); xr[q][bj][1] = *(const f32x4*)(x + o + bj * 128 + 4); } }
#pragma unroll
                for (int q = 0; q < 2; ++q) { const int m = m2 + q; const size_t o = (size_t)(row0 + ai * 128 + m * 16) * D + col0;
#pragma unroll
                    for (int bj = 0; bj < 2; ++bj) { const f32x4 v0 = xr[q][bj][0] + acc[ai][bj][m][0], v1 = xr[q][bj][1] + acc[ai][bj][m][1];
                        u32x4 w; w.x = cvt_pk_bf16(v0[0], v0[1]); w.y = cvt_pk_bf16(v0[2], v0[3]); w.z = cvt_pk_bf16(v1[0], v1[1]); w.w = cvt_pk_bf16(v1[2], v1[3]);
                        *(u32x4*)(H1 + o + bj * 128) = w; } } }
    }
};

__device__ __forceinline__ void phase_router(const Params& p, unsigned char* lds_) {
    typedef float f32x16 __attribute__((ext_vector_type(16)));
    LAS unsigned char* lds = (LAS unsigned char*)lds_;
    LAS float* LPart = (LAS float*)lds;
    LAS float* SsqP = (LAS float*)(lds + 32768);
    LAS float* Lg = (LAS float*)(lds + 32768 + 2048);
    LAS float* rsv = (LAS float*)(lds + 32768 + 2048 + 4352);
    LAS int* selE = (LAS int*)(lds + 40960);
    LAS int* baseE = selE + 128;
    const int tid = otid(), wid = tid >> 6, lane = tid & 63, i = lane & 31, hi = lane >> 5;
    for (int tb = blockIdx.x; tb < NTOK / 32; tb += gridDim.x) {
        const int tok0 = tb * 32;
        {
            const bf16_t* hrow = p.H1() + (size_t)(tok0 + i) * D + wid * 256 + hi * 128;
            const float* gptr = p.norm_ffn + wid * 256 + hi * 128;
            const float* wr = p.w_router + (size_t)(wid * 256 + hi * 128) * NE + i;
            f32x16 acc = {}; float ssq = 0.f;
#pragma unroll 4
            for (int s4 = 0; s4 < 32; ++s4) { const u32x2 hu = *(const u32x2*)(hrow + s4 * 4); const float4 a = make_float4(bflo(hu.x), bfhi(hu.x), bflo(hu.y), bfhi(hu.y)); const float4 g = *(const float4*)(gptr + s4 * 4);
                ssq += a.x * a.x + a.y * a.y + a.z * a.z + a.w * a.w;
                const float b0 = wr[(s4 * 4 + 0) * NE], b1 = wr[(s4 * 4 + 1) * NE], b2 = wr[(s4 * 4 + 2) * NE], b3 = wr[(s4 * 4 + 3) * NE];
                acc = __builtin_amdgcn_mfma_f32_32x32x2f32(a.x * g.x, b0, acc, 0, 0, 0); acc = __builtin_amdgcn_mfma_f32_32x32x2f32(a.y * g.y, b1, acc, 0, 0, 0);
                acc = __builtin_amdgcn_mfma_f32_32x32x2f32(a.z * g.z, b2, acc, 0, 0, 0); acc = __builtin_amdgcn_mfma_f32_32x32x2f32(a.w * g.w, b3, acc, 0, 0, 0); }
#pragma unroll
            for (int r = 0; r < 16; ++r) { const int row = (r & 3) + 8 * (r >> 2) + 4 * hi; LPart[(wid * 32 + row) * 32 + i] = acc[r]; }
            SsqP[(wid * 2 + hi) * 32 + i] = ssq;
        }
        __syncthreads();
#pragma unroll
        for (int q = 0; q < 2; ++q) { const int idx = tid + 512 * q, tok = idx >> 5, e = idx & 31; float s = 0.f, ss = 0.f;
#pragma unroll
            for (int w = 0; w < 8; ++w) s += LPart[(w * 32 + tok) * 32 + e];
#pragma unroll
            for (int j = 0; j < 16; ++j) ss += SsqP[j * 32 + tok];
            const float rs = rsqrtf(ss / D + EPS); Lg[tok * 33 + e] = rs * s + p.b_router[e]; if (e == 0) rsv[tok] = rs; }
        __syncthreads();
#pragma unroll
        for (int q = 0; q < 4; ++q) { const int tok = wid * 4 + q; float cur = Lg[tok * 33 + i]; float tv[4]; int ti[4];
#pragma unroll
            for (int r = 0; r < 4; ++r) { float bv = cur; int bi = i;
#pragma unroll
                for (int o = 16; o >= 1; o >>= 1) { const float ov = __shfl_xor(bv, o); const int oi = __shfl_xor(bi, o); if (ov > bv || (ov == bv && oi < bi)) { bv = ov; bi = oi; } }
                tv[r] = bv; ti[r] = bi; if (i == bi) cur = -3e38f; }
            float ex[4], sm = 0.f;
#pragma unroll
            for (int r = 0; r < 4; ++r) { ex[r] = __expf(tv[r] - tv[0]); sm += ex[r]; }
            if (lane == 0) {
#pragma unroll
                for (int r = 0; r < 4; ++r) { selE[tok * 4 + r] = ti[r]; p.topW()[(size_t)(tok0 + tok) * 4 + r] = ex[r] / sm; } } }
        __syncthreads();
        if (tid < 32) { int c = 0; for (int j = 0; j < 128; ++j) c += (selE[j] == tid) ? 1 : 0; baseE[tid] = c ? atomicAdd(&p.cursor()[tid], c) : 0; }
        __syncthreads();
        if (tid < 128) { const int e = selE[tid]; int rank = 0; for (int j = 0; j < tid; ++j) rank += (selE[j] == e) ? 1 : 0; const int pos = baseE[e] + rank;
            p.list()[e * ECAP + pos] = tok0 + (tid >> 2); p.dest()[(size_t)(tok0 + (tid >> 2)) * 4 + (tid & 3)] = e * ECAP + pos; }
#pragma unroll
        for (int q = 0; q < 4; ++q) { const int tok = wid * 4 + q; const float rs = rsv[tok]; u32x2 hu[8]; float4 g[8];
#pragma unroll
            for (int c8 = 0; c8 < 8; ++c8) { const int col = c8 * 256 + lane * 4; hu[c8] = *(const u32x2*)(p.H1() + (size_t)(tok0 + tok) * D + col); g[c8] = *(const float4*)(p.norm_ffn + col); }
#pragma unroll
            for (int c8 = 0; c8 < 8; ++c8) { const int col = c8 * 256 + lane * 4; const float4 a = make_float4(bflo(hu[c8].x), bfhi(hu[c8].x), bflo(hu[c8].y), bfhi(hu[c8].y));
                *(unsigned*)((unsigned char*)p.HN() + (size_t)(tok0 + tok) * D + col) = pk4_fp8(a.x * rs * g[c8].x, a.y * rs * g[c8].y, a.z * rs * g[c8].z, a.w * rs * g[c8].w); } }
        __syncthreads();
    }
}
constexpr int MT_OFF = 131072, MT_BIAS = 3584;
__device__ __forceinline__ int rfl(int v) { return __builtin_amdgcn_readfirstlane(v); }
template <int NPN>
__device__ __forceinline__ void moe_tables(const Params& p, unsigned char* lds_) {
    LAS int* tab = (LAS int*)((LAS unsigned char*)lds_ + MT_OFF);
    const int tid = otid(), lane = tid & 63;
    if (tid < 32) { const int e = lane, c = p.cursor()[e], ntl = (c + 255) >> 8; int incl = ntl;
#pragma unroll
        for (int o = 1; o < 32; o <<= 1) { const int t = __shfl_up(incl, o); if (lane >= o) incl += t; }
        const int toff = incl - ntl; tab[e] = c; tab[32 + e] = toff * 256;
        for (int j = 0; j < ntl; ++j) { tab[96 + toff + j] = e; tab[256 + toff + j] = j; }
        if (e == 31) tab[64] = incl; }
    __syncthreads();
    { const int T = tab[64], c = blockIdx.x, xs = c & 7, sx = c >> 3, ngrp = (T + 3) >> 2, nblk = NPN == 16 ? ngrp * 2 : ngrp; bool valid = false;
      if (tid < 16) { const int b = tid * 8 + xs; if (b < nblk) { const int g = NPN == 16 ? (b >> 1) : b, half = NPN == 16 ? (b & 1) : 0, tile = 4 * g + (sx & 3), pn = half * 8 + (sx >> 2);
          if (tile < T) { valid = true; const int e = tab[96 + tile], j = tab[256 + tile], cnt = tab[e], cb = tab[32 + e]; LAS int* u = tab + 448 + tid * 8; const int rem = cnt - j * 256;
              if (NPN == 16) { u[0] = tid * 256; u[1] = e * 4096 + pn * 256; u[2] = cb + j * 256; u[3] = pn * 128; u[4] = e; u[5] = rem < 256 ? rem : 256; u[6] = 0; u[7] = e * ECAP + j * 256; }
              else { u[0] = cb + j * 256; u[1] = e * 2048 + pn * 256; u[2] = cb + j * 256; u[3] = pn * 256; u[4] = e; u[5] = 256; u[6] = 0; u[7] = 0; } } } }
      if (tid < 64) { const unsigned long long m = __ballot(valid); if (tid == 0) tab[65] = __popcll(m); } }
    __syncthreads();
    if (NPN == 16) { const int nun = tab[65];
        for (int idx = tid; idx < nun * 256; idx += 512) { const int i = idx >> 8, row = idx & 255, nv = tab[448 + i * 8 + 5], src = tab[448 + i * 8 + 7]; tab[1024 + idx] = p.list()[src + (row < nv ? row : 0)]; } }
    { const int nun = tab[65]; LAS float* bl = (LAS float*)(tab + MT_BIAS);
        for (int idx = tid; idx < nun * 256; idx += 512) { const int i = idx >> 8, c = idx & 255, e = tab[448 + i * 8 + 4], c0 = tab[448 + i * 8 + 3];
            bl[idx] = NPN == 16 ? p.b1[(size_t)e * 4096 + (c < 128 ? c0 + c : 2048 + c0 + c - 128)] : p.b2[(size_t)e * D + c0 + c]; } }
    __syncthreads();
}
struct SchedMoe1 { static constexpr bool BTILED = true; static constexpr bool GATHER = true; const LAS int* tab;
    __device__ bool next(int i, pg8::Unit& u) const { if (i >= rfl(tab[65])) return false; const LAS int* q = tab + 448 + i * 8;
        u.a0 = rfl(q[0]); u.b0 = rfl(q[1]); u.r0 = rfl(q[2]); u.c0 = rfl(q[3]); u.aux = rfl(q[4]); u.nv = rfl(q[5]); u.rot = rfl(q[6]); u.bo = i * 256; return true; }
    __device__ int arow(const pg8::Unit& u, int row) const { return tab[1024 + u.a0 + row]; } };
struct SchedMoe2 { static constexpr bool BTILED = true; static constexpr bool GATHER = false; const LAS int* tab;
    __device__ bool next(int i, pg8::Unit& u) const { if (i >= rfl(tab[65])) return false; const LAS int* q = tab + 448 + i * 8;
        u.a0 = rfl(q[0]); u.b0 = rfl(q[1]); u.r0 = rfl(q[2]); u.c0 = rfl(q[3]); u.aux = rfl(q[4]); u.nv = rfl(q[5]); u.rot = rfl(q[6]); u.bo = i * 256; return true; }
    __device__ int arow(const pg8::Unit&, int) const { return 0; } };
struct EpiSwiglu { __device__ __forceinline__ pg8::PF prefetch(const pg8::Unit&, int) const { return pg8::PF{0u, 0u, 0u, 0u}; } __device__ __forceinline__ bool keep(const pg8::Unit&) const { return false; } static constexpr bool PERM = true; bf16_t* ACT; const LAS float* bl;
    __device__ __forceinline__ void operator()(f32x4 (&acc)[2][2][4][2], const pg8::Unit& u, int wr, int wc, int fr, int fq) const {
        const int row0 = u.r0 + wr * 64 + fr, col0 = u.c0 + wc * 32 + 8 * fq; const LAS float* bg = bl + u.bo + wc * 32 + 8 * fq;
        f32x4 bgv[2], blv[2];
#pragma unroll
        for (int n = 0; n < 2; ++n) { bgv[n] = *(const LAS f32x4*)(bg + 4 * n); blv[n] = *(const LAS f32x4*)(bg + 128 + 4 * n); }
#pragma unroll
        for (int ai = 0; ai < 2; ++ai)
#pragma unroll
            for (int m = 0; m < 4; ++m) { f32x4 o[2];
#pragma unroll
                for (int n = 0; n < 2; ++n) { const f32x4 g4 = acc[ai][0][m][n] * (1.0f / W8_SCALE) + bgv[n], l4 = acc[ai][1][m][n] * (1.0f / W8_SCALE) + blv[n];
#pragma unroll
                    for (int j = 0; j < 4; ++j) { const float g = fminf(g4[j], 7.0f), l = fminf(fmaxf(l4[j], -7.0f), 7.0f); o[n][j] = g * __builtin_amdgcn_rcpf(1.0f + __expf(-1.702f * g)) * (l + 1.0f); } }
                u32x2 w; w.x = pk4_fp8(o[0][0], o[0][1], o[0][2], o[0][3]); w.y = pk4_fp8(o[1][0], o[1][1], o[1][2], o[1][3]);
                *(u32x2*)((unsigned char*)ACT + (size_t)(row0 + ai * 128 + m * 16) * DFF + col0) = w; }
    }
};
struct EpiY { __device__ __forceinline__ pg8::PF prefetch(const pg8::Unit&, int) const { return pg8::PF{0u, 0u, 0u, 0u}; } __device__ __forceinline__ bool keep(const pg8::Unit&) const { return false; } static constexpr bool PERM = true; bf16_t* Y; const LAS float* bl;
    __device__ __forceinline__ void operator()(f32x4 (&acc)[2][2][4][2], const pg8::Unit& u, int wr, int wc, int fr, int fq) const {
        const int row0 = u.r0 + wr * 64 + fr, col0 = u.c0 + wc * 32 + 8 * fq; const LAS float* bb = bl + u.bo + wc * 32 + 8 * fq;
        f32x4 bv[2][2];
#pragma unroll
        for (int bj = 0; bj < 2; ++bj)
#pragma unroll
            for (int n = 0; n < 2; ++n) bv[bj][n] = *(const LAS f32x4*)(bb + bj * 128 + 4 * n);
#pragma unroll
        for (int ai = 0; ai < 2; ++ai)
#pragma unroll
            for (int m = 0; m < 4; ++m) { bf16_t* rowp = Y + (size_t)(row0 + ai * 128 + m * 16) * D + col0;
#pragma unroll
                for (int bj = 0; bj < 2; ++bj) { const f32x4 v0 = acc[ai][bj][m][0] * (1.0f / W8_SCALE) + bv[bj][0], v1 = acc[ai][bj][m][1] * (1.0f / W8_SCALE) + bv[bj][1];
                    u32x4 w; w.x = cvt_pk_bf16(v0[0], v0[1]); w.y = cvt_pk_bf16(v0[2], v0[3]); w.z = cvt_pk_bf16(v1[0], v1[1]); w.w = cvt_pk_bf16(v1[2], v1[3]);
                    *(u32x4*)(rowp + bj * 128) = w; } }
    }
};
__device__ __forceinline__ void phase_final(const Params& p) {
    const int tid = otid(), wid = tid >> 6, lane = tid & 63;
    int cb = 0; { const int c = lane < NE ? p.cursor()[lane] : 0; int pad = ((c + 255) >> 8) << 8; int incl = pad;
#pragma unroll
        for (int o = 1; o < 32; o <<= 1) { const int t = __shfl_up(incl, o); if ((lane & 31) >= o) incl += t; }
        cb = incl - pad; }
    static_assert(NTOK == NWG * 8 * 4, "final: four tokens per wave");
    int4 dA[4]; float4 wA[4];
#pragma unroll
    for (int q = 0; q < 4; ++q) { const int tk = blockIdx.x * 8 + wid + q * NWG * 8; dA[q] = *(const int4*)(p.dest() + (size_t)tk * 4); wA[q] = *(const float4*)(p.topW() + (size_t)tk * 4); }
    u32x2 hb[8], yb[4][8]; float4 g[8];
#pragma unroll
    for (int c8 = 0; c8 < 8; ++c8) g[c8] = *(const float4*)(p.norm_final + c8 * 256 + lane * 4);
#define FIN_LOAD(q_) do { const int tk_ = blockIdx.x * 8 + wid + (q_) * NWG * 8; const int dd_[4] = {dA[q_].x, dA[q_].y, dA[q_].z, dA[q_].w}; \
        _Pragma("unroll") for (int c8 = 0; c8 < 8; ++c8) hb[c8] = *(const u32x2*)(p.H1() + (size_t)tk_ * D + c8 * 256 + lane * 4); \
        _Pragma("unroll") for (int k = 0; k < 4; ++k) { const size_t yr_ = (size_t)(__shfl(cb, dd_[k] >> 13) + (dd_[k] & (ECAP - 1))) * D; \
            _Pragma("unroll") for (int c8 = 0; c8 < 8; ++c8) yb[k][c8] = *(const u32x2*)(p.Y() + yr_ + c8 * 256 + lane * 4); } } while (0)
    FIN_LOAD(0);
#pragma unroll
    for (int q = 0; q < 4; ++q) { const int tk = blockIdx.x * 8 + wid + q * NWG * 8;
        const float w[4] = {wA[q].x, wA[q].y, wA[q].z, wA[q].w};
        float4 v[8]; float ss = 0.f;
#pragma unroll
        for (int c8 = 0; c8 < 8; ++c8) { float4 a = make_float4(bflo(hb[c8].x), bfhi(hb[c8].x), bflo(hb[c8].y), bfhi(hb[c8].y));
#pragma unroll
            for (int k = 0; k < 4; ++k) { const u32x2 y = yb[k][c8]; a.x += w[k] * bflo(y.x); a.y += w[k] * bfhi(y.x); a.z += w[k] * bflo(y.y); a.w += w[k] * bfhi(y.y); }
            v[c8] = a; ss += a.x * a.x + a.y * a.y + a.z * a.z + a.w * a.w; }
        if (q < 3) FIN_LOAD(q + 1);
        ss = wave_sum(ss); const float rs = rsqrtf(ss / D + EPS);
#pragma unroll
        for (int c8 = 0; c8 < 8; ++c8) { const int col = c8 * 256 + lane * 4;
            *(float4*)(p.out + (size_t)tk * D + col) = make_float4(v[c8].x * rs * g[c8].x, v[c8].y * rs * g[c8].y, v[c8].z * rs * g[c8].z, v[c8].w * rs * g[c8].w); }
    }
#undef FIN_LOAD
}

#define XB_TMO      128
#define XB_XCNT(j)  (256  + 64 * (j))
#define XB_XSUB(j)  (1280 + 64 * (j))
#define XB_XGEN(j)  (2304 + 64 * (j))
#define XB_TOP      3328
#define XB_TOPGEN   3392
#define XCD_BAR_WORDS 3456
#define XB_SPIN_CAP (1u << 18)

__device__ __forceinline__ unsigned xb_ld(unsigned* p)              { return __hip_atomic_load(p, __ATOMIC_RELAXED, __HIP_MEMORY_SCOPE_AGENT); }
__device__ __forceinline__ unsigned xb_add(unsigned* p, unsigned v) { return __hip_atomic_fetch_add(p, v, __ATOMIC_RELAXED, __HIP_MEMORY_SCOPE_AGENT); }
__device__ __forceinline__ unsigned xb_xcc_id() { return (unsigned)__builtin_amdgcn_s_getreg((3 << 11) | 20) & 0xFu; }
#define XB_SPIN(cond, bar) do { unsigned _sp = 0; while (cond) { __builtin_amdgcn_s_sleep(1); \
    if ((++_sp & 255u) == 0u) { if (xb_ld(&(bar)[XB_TMO])) break; if (_sp > XB_SPIN_CAP) { atomicAdd(&(bar)[XB_TMO], 1u); break; } } } } while (0)

struct XcdBarrier {
    unsigned* bar; unsigned x;
    volatile LAS unsigned* st;
};

__device__ __forceinline__ XcdBarrier xcd_barrier_post(unsigned* bar, volatile LAS unsigned* st) {
    XcdBarrier b; b.bar = bar; b.x = xb_xcc_id(); b.st = st;
    if (threadIdx.x == 0) (void)xb_add(&bar[XB_XCNT(b.x)], 1u);
    return b;
}
__device__ __forceinline__ void xcd_barrier_complete(unsigned* bar, unsigned x, unsigned& nloc, unsigned& nx) {
    const unsigned G = gridDim.x * gridDim.y * gridDim.z;
    unsigned sum, cnt, mine, sp = 0u;
    for (;;) {
        sum = 0u; cnt = 0u; mine = 0u;
#pragma unroll
        for (unsigned j = 0; j < 16; ++j) { const unsigned c = xb_ld(&bar[XB_XCNT(j)]); sum += c; cnt += (c > 0u) ? 1u : 0u; mine = (j == x) ? c : mine; }
        if (sum == G) break;
        __builtin_amdgcn_s_sleep(1);
        if ((++sp & 255u) == 0u) { if (xb_ld(&bar[XB_TMO])) break; if (sp > XB_SPIN_CAP) { atomicAdd(&bar[XB_TMO], 1u); break; } }
    }
    nloc = mine > 0u ? mine : 1u; nx = cnt > 0u ? cnt : 1u;
}

__device__ __forceinline__ void xcd_barrier(const XcdBarrier& b) {
    asm volatile("s_waitcnt vmcnt(0)" ::: "memory");
    __syncthreads();
    if (threadIdx.x == 0) {
        unsigned* bar = b.bar;
        __builtin_amdgcn_s_waitcnt(0);
        unsigned nloc = b.st[0], nx = b.st[1];
        if (nloc == 0u) { xcd_barrier_complete(bar, b.x, nloc, nx); b.st[0] = nloc; b.st[1] = nx; }
        const unsigned old = xb_add(&bar[XB_XSUB(b.x)], 1u);
        const unsigned gen = old / nloc;
        if (old + 1u == (gen + 1u) * nloc) {
            __builtin_amdgcn_fence(__ATOMIC_RELEASE, "agent");
            asm volatile("s_waitcnt vmcnt(0)" ::: "memory");
            const unsigned og = xb_add(&bar[XB_TOP], 1u);
            const unsigned tg = og / nx;
            if (og + 1u == (tg + 1u) * nx) xb_add(&bar[XB_TOPGEN], 1u);
            else XB_SPIN(xb_ld(&bar[XB_TOPGEN]) == tg, bar);
            __builtin_amdgcn_fence(__ATOMIC_ACQUIRE, "agent");
            xb_add(&bar[XB_XGEN(b.x)], 1u);
            asm volatile("s_waitcnt vmcnt(0)" ::: "memory");
        } else {
            XB_SPIN(xb_ld(&bar[XB_XGEN(b.x)]) == gen, bar);
            __builtin_amdgcn_fence(__ATOMIC_ACQUIRE, "agent");
            asm volatile("s_waitcnt vmcnt(0)" ::: "memory");
        }
    }
    __syncthreads();
}


__device__ __forceinline__ Params load_params() {
    auto kp = __builtin_amdgcn_kernarg_segment_ptr(); asm volatile("" : "+s"(kp));
    Params p; __builtin_memcpy(&p, (const void*)kp, sizeof(Params)); return p;
}
__global__ void __launch_bounds__(512, 2) mk_fwd(Args a) {
    extern __shared__ __attribute__((aligned(16))) unsigned char lds[];
    const int lo = a.ph_lo, hi = a.ph_hi;
#define IN(k) (lo <= (k) && (k) < hi)
    volatile LAS unsigned* xbw = (volatile LAS unsigned*)((LAS unsigned char*)lds + (LDS_BYTES - 16));
    if (threadIdx.x < 4) xbw[threadIdx.x] = 0u;
    __syncthreads();
    XcdBarrier bar; bar.bar = (unsigned*)a.p.ws; bar.x = 0; bar.st = xbw;
    if (hi - lo > 1) bar = xcd_barrier_post((unsigned*)a.p.ws, xbw);
#define SEAM(k) do { if (IN(k) && IN((k) + 1)) xcd_barrier(bar); } while (0)
    if (IN(0)) { const Params p = load_params(); phase0(p, lds); }
    SEAM(0);
    if (IN(1)) { const Params p = load_params();
        if ((int)blockIdx.x < P1_WORKERS) {
        { SchedProj S; S.T.init(NTOK / 256, 6144 / 256, P1_WORKERS, blockIdx.x, 4);     EpiProj E{p.P(), p.biasP(), 1.0f};
          pg8::gemm_phase<EpiProj, SchedProj>((LAS unsigned char*)lds, p.XN(), p.WinT(), 2048, S, E); }
        { SchedGate8 S; S.T.init(NTOK / 256, 4096 / 256, P1_WORKERS, blockIdx.x, 4); EpiProj E{p.P(), p.biasP(), 1.0f / W8_SCALE};
          pg8::gemm_phase<EpiProj, SchedGate8, 1>((LAS unsigned char*)lds, p.XN8(), p.WG8T(), 2048, S, E); }
        if (blockIdx.x < 128) proj_meta(p, blockIdx.x, (float*)lds); }
        else convert_ring(p, lds, (int)blockIdx.x - P1_WORKERS, NWG - P1_WORKERS); }
    SEAM(1);
    if (IN(2)) { const Params p = load_params(); mls::m0_conv_gates(p); phase_attn(p, lds); }
    SEAM(2);
    if (IN(3)) { const Params p = load_params(); phase_yda(p); mls::m1_summaries(p, lds); }
    SEAM(3);
    if (IN(4)) { const Params p = load_params(); mls::m2_scan(p); }
    SEAM(4);
    if (IN(5)) { const Params p = load_params(); mls::m3_outputs(p, lds); }
    SEAM(5);
    if (IN(6)) { const Params p = load_params(); SchedBranch S; S.T.init(NTOK / 256, D / 256, gridDim.x, blockIdx.x); EpiBranch E{p.MIX(), p.P()};
        pg8::gemm_phase<EpiBranch, SchedBranch>((LAS unsigned char*)lds, p.YDM(), p.WbrT(), 1024, S, E); }
    SEAM(6);
    if (IN(7)) { const Params p = load_params(); SchedOut S; S.T.init(NTOK / 256, D / 256, gridDim.x, blockIdx.x); EpiOut E{p.x, p.H1()};
        pg8::gemm_phase<EpiOut, SchedOut>((LAS unsigned char*)lds, p.MIX(), p.WoutT(), 2048, S, E); }
    SEAM(7);
    if (IN(8)) { const Params p = load_params(); phase_router(p, lds); }
    SEAM(8);
    if (IN(9)) { const Params& p = a.p; moe_tables<16>(p, lds); SchedMoe1 S{(const LAS int*)((LAS unsigned char*)lds + MT_OFF)}; EpiSwiglu E{p.ACT(), (const LAS float*)((LAS unsigned char*)lds + MT_OFF) + MT_BIAS};
        pg8::gemm_phase<EpiSwiglu, SchedMoe1, 1>((LAS unsigned char*)lds, p.HN(), p.W1T(), 2048, S, E); }
    SEAM(9);
    if (IN(10)) { const Params p = load_params(); moe_tables<8>(p, lds); SchedMoe2 S{(const LAS int*)((LAS unsigned char*)lds + MT_OFF)}; EpiY E{p.Y(), (const LAS float*)((LAS unsigned char*)lds + MT_OFF) + MT_BIAS};
        pg8::gemm_phase<EpiY, SchedMoe2, 1>((LAS unsigned char*)lds, p.ACT(), p.W2T(), 2048, S, E); }
    SEAM(10);
    if (IN(11)) { const Params p = load_params(); phase_final(p); }
#undef SEAM
#undef IN
}

static void launch_mk(hipStream_t st, const Params& p, int lo, int hi) {
    Args a{}; a.p = p; a.ph_lo = lo; a.ph_hi = hi;
    hipLaunchKernelGGL(mk_fwd, dim3(NWG), dim3(512), LDS_BYTES, st, a);
}

extern "C" void kernel_launch(void* const* d_in, const int* in_sizes, int n_in, void* d_out, int out_size, void* d_ws, size_t ws_size, hipStream_t stream) {
    static int ready = 0;
    if (!ready) {
        if (hipFuncSetAttribute((const void*)mk_fwd, hipFuncAttributeMaxDynamicSharedMemorySize, LDS_BYTES) != hipSuccess) { fprintf(stderr, "kernel_launch: hipFuncSetAttribute failed\n"); return; }
        ready = 1;
    }
    Params p{};
    p.x = (const float*)d_in[0]; p.meta = (const float*)d_in[1]; p.rel_bias = (const float*)d_in[2];
    p.norm_mix = (const float*)d_in[3]; p.w_in = (const float*)d_in[4]; p.conv_w = (const float*)d_in[5];
    p.gate_bias = (const float*)d_in[6]; p.lamp = (const float*)d_in[7]; p.subln = (const float*)d_in[8];
    p.w_bda = (const float*)d_in[9]; p.w_bm = (const float*)d_in[10]; p.w_gate = (const float*)d_in[11];
    p.b_gate = (const float*)d_in[12]; p.w_out = (const float*)d_in[13]; p.norm_ffn = (const float*)d_in[14];
    p.w_router = (const float*)d_in[15]; p.b_router = (const float*)d_in[16]; p.w1 = (const float*)d_in[17];
    p.b1 = (const float*)d_in[18]; p.w2 = (const float*)d_in[19]; p.b2 = (const float*)d_in[20];
    p.norm_final = (const float*)d_in[21];
    p.out = (float*)d_out;
    size_t off = 0;
    p.ws = (unsigned char*)d_ws; off = WS_END;
    if (off > ws_size) { fprintf(stderr, "kernel_launch: workspace too small: need %zu have %zu\n", off, ws_size); return; }
    if (hipMemsetAsync(p.ctl(), 0, 65536, stream) != hipSuccess) { fprintf(stderr, "kernel_launch: memset failed\n"); return; }
#ifndef PROBE_DUP_MASK
    launch_mk(stream, p, 0, 12);
#else
    for (int ph = 0; ph < 12; ++ph) { launch_mk(stream, p, ph, ph + 1); if (((PROBE_DUP_MASK) >> ph) & 1) launch_mk(stream, p, ph, ph + 1); }
#endif
}
```

```cpp
#include <hip/hip_runtime.h>
#include <cstdio>
#include <cstdint>

constexpr int NB = 2, SEQ = 4096, D = 2048, NMETA = 16, PADF = 112, L = 4112, LP = 4224, R = NB * LP;
constexpr int INC = 6160;
constexpr int C_DAQ = 0, C_DAK = 1024, C_DAV = 2048, C_MQ = 3072, C_MK = 3584, C_MV = 4096, C_MO = 5120, C_MG = 6144;
constexpr int NE = 32, TOPK = 4, DFF = 2048;
constexpr float EPS = 1e-6f;
constexpr int MAXSLOT = R * TOPK;

__device__ __forceinline__ float wave_sum(float v) { for (int o = 32; o >= 1; o >>= 1) v += __shfl_xor(v, o); return v; }
__device__ __forceinline__ float wave_max(float v) { for (int o = 32; o >= 1; o >>= 1) v = fmaxf(v, __shfl_xor(v, o)); return v; }
__device__ __forceinline__ float block_sum256(float v, float* red) {
    v = wave_sum(v); __syncthreads(); if ((threadIdx.x & 63) == 0) red[threadIdx.x >> 6] = v; __syncthreads();
    return red[0] + red[1] + red[2] + red[3];
}
__device__ __forceinline__ float block_max256(float v, float* red) {
    v = wave_max(v); __syncthreads(); if ((threadIdx.x & 63) == 0) red[threadIdx.x >> 6] = v; __syncthreads();
    return fmaxf(fmaxf(red[0], red[1]), fmaxf(red[2], red[3]));
}
__device__ __forceinline__ float sigmoidf_(float x) { return 1.0f / (1.0f + __expf(-x)); }
__device__ __forceinline__ float logsigmoidf_(float x) { return fminf(x, 0.f) - log1pf(__expf(-fabsf(x))); }
__device__ __forceinline__ int t5_bucket(int rel) {
    const int n = rel < 0 ? -rel : rel; int v;
    if (n < 8) v = n; else { const int t = n * n; int k = 0; while (k < 7 && t >= (128 << k)) ++k; v = 8 + k; if (v > 15) v = 15; }
    return v + (rel > 0 ? 16 : 0);
}

#define LAS __attribute__((address_space(3)))
typedef unsigned short bf16_t;
typedef short bf16x8 __attribute__((ext_vector_type(8)));
typedef float f32x4 __attribute__((ext_vector_type(4)));
typedef float f32x2 __attribute__((ext_vector_type(2)));
typedef unsigned u32x4 __attribute__((ext_vector_type(4)));
typedef unsigned u32x2 __attribute__((ext_vector_type(2)));
constexpr int NPROJ = 10240;
constexpr int LDS_BYTES = 163840;
constexpr int NWG = 256;
#ifndef P1_WORKERS_
#define P1_WORKERS_ 136
#endif
constexpr int P1_WORKERS = P1_WORKERS_;
constexpr int NTOK = NB * SEQ;
constexpr int ECAP = 8192;
constexpr int MOE_ROWS = NTOK * TOPK + NE * 256;
constexpr int TAB_OFF = 131072;

__device__ __forceinline__ int otid() { int t = threadIdx.x; asm volatile("" : "+v"(t)); return t; }
__device__ __forceinline__ unsigned cvt_pk_bf16(float lo, float hi) { unsigned r; asm volatile("v_cvt_pk_bf16_f32 %0, %1, %2" : "=v"(r) : "v"(lo), "v"(hi)); return r; }
__device__ __forceinline__ unsigned pk4_fp8(float a, float b, float c, float d) { int w = __builtin_amdgcn_cvt_pk_fp8_f32(a, b, 0, false); w = __builtin_amdgcn_cvt_pk_fp8_f32(c, d, w, true); return (unsigned)w; }
typedef int i32x8 __attribute__((ext_vector_type(8)));
constexpr float W8_SCALE = 64.0f;
__device__ __forceinline__ float bf2f(bf16_t b) { return __uint_as_float(((unsigned)b) << 16); }
__device__ __forceinline__ float bflo(unsigned w) { return __uint_as_float(w << 16); }
__device__ __forceinline__ float bfhi(unsigned w) { return __uint_as_float(w & 0xffff0000u); }

constexpr size_t al256(size_t x) { return (x + 255) / 256 * 256; }
constexpr size_t WS_CTL = 0;
constexpr size_t WS_WINT = WS_CTL + 65536;
constexpr size_t WS_WBRT = WS_WINT + al256((size_t)NPROJ * 2048 * 2);
constexpr size_t WS_WOUTT = WS_WBRT + al256((size_t)4096 * 1024 * 2);
constexpr size_t WS_W1T = WS_WOUTT + al256((size_t)2048 * 2048 * 2);
constexpr size_t WS_W2T = WS_W1T + al256((size_t)NE * 4096 * 2048 * 2);
constexpr size_t WS_XN = WS_W2T + al256((size_t)NE * 2048 * 2048 * 2);
constexpr size_t WS_GATES = WS_XN + al256((size_t)R * D * 2);
constexpr size_t WS_BIASP = WS_GATES + al256((size_t)R * 16 * 4);
constexpr size_t WS_P = WS_BIASP + al256((size_t)NPROJ * 4);
constexpr size_t WS_YDM = WS_P + al256((size_t)R * NPROJ * 2);
constexpr size_t WS_OS = WS_YDM + al256((size_t)2 * NTOK * 1024 * 2);
constexpr size_t WS_TMIX = WS_OS + al256((size_t)NTOK * 1024 * 4);
constexpr size_t WS_MIX = WS_TMIX + al256((size_t)NTOK * D * 4);
constexpr size_t WS_H1 = WS_MIX + al256((size_t)NTOK * D * 2);
constexpr size_t WS_HN = WS_H1 + al256((size_t)NTOK * D * 4);
constexpr size_t WS_TOPW = WS_HN + al256((size_t)NTOK * D * 2);
constexpr size_t WS_DEST = WS_TOPW + al256((size_t)NTOK * 4 * 4);
constexpr size_t WS_LIST = WS_DEST + al256((size_t)NTOK * 4 * 4);
constexpr size_t WS_ACT = WS_LIST + al256((size_t)NE * ECAP * 4);
constexpr size_t WS_Y = WS_ACT + al256((size_t)MOE_ROWS * DFF * 2);
constexpr size_t WS_QC = WS_Y + al256((size_t)MOE_ROWS * D * 2);
constexpr size_t WS_KC = WS_QC + al256((size_t)R * 512 * 2);
constexpr size_t WS_GB = WS_KC + al256((size_t)R * 512 * 2);
constexpr size_t WS_GA = WS_GB + al256((size_t)16 * LP * 4);
constexpr size_t WS_GPM = WS_GA + al256((size_t)16 * LP * 4);
constexpr size_t WS_CS = WS_GPM + al256((size_t)16 * LP * 4);
constexpr size_t WS_DC = WS_CS + al256((size_t)16 * 33 * 2 * 4);
constexpr size_t WS_DN = WS_DC + al256((size_t)16 * 33 * 128 * 256 * 4);
constexpr size_t WS_CST = WS_DN + al256((size_t)16 * 33 * 128 * 4);
constexpr size_t WS_NST = WS_CST + al256((size_t)16 * 33 * 128 * 256 * 2);
constexpr size_t WS_MST = WS_NST + al256((size_t)16 * 33 * 128 * 4);
constexpr size_t WS_HS = WS_MST + al256((size_t)16 * 33 * 4);
constexpr size_t WS_MTAB = WS_HS + al256((size_t)NTOK * 1024 * 4);
constexpr size_t WS_XN8 = WS_MTAB + al256((size_t)2 * NWG * 512 * 4);
constexpr size_t WS_WG8T = WS_XN8 + al256((size_t)R * D);
constexpr size_t WS_END = WS_WG8T + al256((size_t)4096 * 2048);
struct Params {
    const float *x, *meta, *rel_bias, *norm_mix, *w_in, *conv_w, *gate_bias, *lamp, *subln, *w_bda, *w_bm, *w_gate, *b_gate, *w_out, *norm_ffn, *w_router, *b_router, *w1, *b1, *w2, *b2, *norm_final;
    float* out; unsigned char* ws;
#define WSP(name, T, off) __device__ __host__ __forceinline__ T* name() const { return (T*)(ws + (off)); }
    WSP(ctl, unsigned, WS_CTL) WSP(cursor, int, WS_CTL + 16384)
    WSP(WinT, bf16_t, WS_WINT) WSP(WbrT, bf16_t, WS_WBRT) WSP(WoutT, bf16_t, WS_WOUTT) WSP(W1T, bf16_t, WS_W1T) WSP(W2T, bf16_t, WS_W2T)
    WSP(XN, bf16_t, WS_XN) WSP(gates, float, WS_GATES) WSP(biasP, float, WS_BIASP) WSP(P, bf16_t, WS_P) WSP(YDM, bf16_t, WS_YDM) WSP(OS, float, WS_OS) WSP(Tmix, float, WS_TMIX)
    WSP(MIX, bf16_t, WS_MIX) WSP(H1, bf16_t, WS_H1) WSP(HN, bf16_t, WS_HN) WSP(topW, float, WS_TOPW) WSP(dest, int, WS_DEST) WSP(list, int, WS_LIST) WSP(ACT, bf16_t, WS_ACT) WSP(Y, bf16_t, WS_Y)
    WSP(Qc, bf16_t, WS_QC) WSP(Kc, bf16_t, WS_KC) WSP(GB, float, WS_GB) WSP(GA, float, WS_GA) WSP(GPM, float, WS_GPM) WSP(CS, float, WS_CS) WSP(DC, float, WS_DC) WSP(DN, float, WS_DN)
    WSP(Cst, bf16_t, WS_CST) WSP(Nst, float, WS_NST) WSP(Mst, float, WS_MST) WSP(HS, float, WS_HS) WSP(mtab, int, WS_MTAB) WSP(XN8, unsigned char, WS_XN8) WSP(WG8T, unsigned char, WS_WG8T)
#undef WSP
};
struct Args { Params p; int ph_lo, ph_hi; };

__device__ __forceinline__ int tok2prow(int tok) { return (tok >> 12) * LP + PADF + NMETA + (tok & 4095); }
namespace pg8 {
constexpr int BM = 256, BK = 64, HALF = 128, HTB = HALF * BK * 2, STAGE_BYTES = 8 * HTB, NXCD = 8, WGM = 8;
__host__ __device__ __forceinline__ int lds_byte(int r, int c) { const int st = (r >> 4) * 2 + (c >> 5), rr = r & 15, cc = c & 31, ob = rr * 64 + cc * 2; return st * 1024 + (ob ^ (((ob >> 9) & 1) << 5)); }
__host__ __device__ __forceinline__ void stage_rc(int b, int& Rr, int& C) { const int st = b / 1024, sb = b % 1024, swz = sb ^ (((sb >> 9) & 1) << 5); Rr = (st >> 1) * 16 + swz / 64; C = (st & 1) * 32 + (swz % 64) / 2; }
__host__ __device__ __forceinline__ int perm32(int rho) { const int n = rho >> 4, i = rho & 15; return 8 * (i >> 2) + 4 * n + (i & 3); }
struct Unit { int a0, b0, r0, c0, aux, nv, rot, bo; };
struct PF { unsigned a, b, c, d; };
struct TileOrder {
    int nM, nN, nwg, G, c, wgm;
    __device__ void init(int nM_, int nN_, int G_, int c_, int wgm_ = WGM) { nM = nM_; nN = nN_; nwg = nM * nN; G = G_; c = c_; wgm = wgm_; }
    __device__ bool tile(int i, int& pm, int& pn) const {
        const long Lx = (long)i * G + c; if (Lx >= nwg) return false;
        int wgid = (int)Lx; { const int q = nwg / NXCD, r = nwg % NXCD, xcd = wgid % NXCD, off = wgid / NXCD; wgid = (xcd < r ? xcd * (q + 1) : r * (q + 1) + (xcd - r) * q) + off; }
        const int nig = wgm * nN, gid = wgid / nig, fm = gid * wgm, gsz = (nM - fm) < wgm ? (nM - fm) : wgm;
        pm = fm + ((wgid % nig) % gsz); pn = (wgid % nig) / gsz; return true;
    }
};
template <class Epi, class Sched, int ES = 2>
__device__ __forceinline__ void gemm_phase(LAS unsigned char* lds, const void* A, const void* Bt, const int K, const Sched& S, const Epi& E) {
    const int tid = threadIdx.x, wid = __builtin_amdgcn_readfirstlane(tid >> 6), lane = tid & 63, wr = wid >> 2, wc = wid & 3, fr = lane & 15, fq = lane >> 4;
    const int nt = K * ES / 128;
    unsigned voffA[2], voffB[2];
#pragma unroll
    for (int i = 0; i < 2; ++i) { int Rr, C; stage_rc(tid * 16 + i * 8192, Rr, C); const int Rb = Epi::PERM ? ((Rr & ~31) + perm32(Rr & 31)) : Rr;
        voffA[i] = (unsigned)(Rr * K * ES + C * 2); voffB[i] = Sched::BTILED ? (unsigned)(Rb * 128 + C * 2) : (unsigned)(Rb * K * ES + C * 2); }
    const size_t kstep = (size_t)(BK * 2);
    const size_t hstep = (size_t)HALF * K * ES;
    const size_t kstepB = Sched::BTILED ? (size_t)32768 : kstep, hstepB = Sched::BTILED ? (size_t)(HALF * 128) : hstep;
    const size_t rstep = (size_t)K * ES;
    const unsigned ldsw = (unsigned)wid * 1024u;
    const int aoff = ES == 2 ? lds_byte(wr * 64 + fr, fq * 8) : lds_byte(wr * 64 + fr, fq * 16), boff = ES == 2 ? lds_byte(wc * 32 + fr, fq * 8) : lds_byte(wc * 32 + fr, fq * 16);
#define PG8_SA(b, h) (((b) * 2 + (h)) * HTB)
#define PG8_SB(b, h) ((4 + (b) * 2 + (h)) * HTB)
#define PG8_STAGE(bufoff, gbase, voff) do { _Pragma("unroll") for (int _i = 0; _i < 2; ++_i) \
        __builtin_amdgcn_global_load_lds((const unsigned*)((const char*)(gbase) + (voff)[_i]), (LAS unsigned*)(lds + (bufoff) + ldsw + _i * 8192), 16, 0, 0); } while (0)
#define PG8_LD32(ptr) __builtin_bit_cast(i32x8, __builtin_shufflevector(*(const LAS u32x4*)(ptr), *(const LAS u32x4*)((ptr) + 16), 0, 1, 2, 3, 4, 5, 6, 7))
#define PG8_LDA(dst, b, h) do { if constexpr (ES == 2) { _Pragma("unroll") for (int m = 0; m < 4; ++m) _Pragma("unroll") for (int k = 0; k < 2; ++k) dst[m][k] = *(const LAS bf16x8*)(lds + PG8_SA(b, h) + aoff + m * 2048 + k * 1024); } \
        else { _Pragma("unroll") for (int m = 0; m < 4; ++m) dst##8[m] = PG8_LD32(lds + PG8_SA(b, h) + aoff + m * 2048); } } while (0)
#define PG8_LDB(dst, b, h) do { if constexpr (ES == 2) { _Pragma("unroll") for (int n = 0; n < 2; ++n) _Pragma("unroll") for (int k = 0; k < 2; ++k) dst[n][k] = *(const LAS bf16x8*)(lds + PG8_SB(b, h) + boff + n * 2048 + k * 1024); } \
        else { _Pragma("unroll") for (int n = 0; n < 2; ++n) dst##8[n] = PG8_LD32(lds + PG8_SB(b, h) + boff + n * 2048); } } while (0)
#define PG8_MMA(ai, bj, At, Bt_) do { int sc127_ = 127; if constexpr (ES == 1) asm volatile("" : "+v"(sc127_)); __builtin_amdgcn_s_setprio(1); if constexpr (ES == 2) { _Pragma("unroll") for (int m = 0; m < 4; ++m) _Pragma("unroll") for (int n = 0; n < 2; ++n) _Pragma("unroll") for (int k = 0; k < 2; ++k) \
        acc[ai][bj][m][n] = __builtin_amdgcn_mfma_f32_16x16x32_bf16(Bt_[n][k], At[m][k], acc[ai][bj][m][n], 0, 0, 0); } else { _Pragma("unroll") for (int m = 0; m < 4; ++m) _Pragma("unroll") for (int n = 0; n < 2; ++n) \
        asm volatile("v_mfma_scale_f32_16x16x128_f8f6f4 %0, %1, %2, %0, %3, %3 op_sel_hi:[0,0,0]" : "+v"(acc[ai][bj][m][n]) : "v"(Bt_##8[n]), "v"(At##8[m]), "v"(sc127_)); } __builtin_amdgcn_s_setprio(0); } while (0)
#define PG8_WAIT_V(n) asm volatile("s_waitcnt vmcnt(" #n ")" ::: "memory")
#define PG8_WAIT_L(n) asm volatile("s_waitcnt lgkmcnt(" #n ")" ::: "memory")
#define PG8_BAR __builtin_amdgcn_s_barrier()
#define PG8_SCHED __builtin_amdgcn_sched_barrier(0)
    Unit cur, nxt; int ui = 0;
    if (!S.next(0, cur)) return;
    f32x4 acc[2][2][4][2];
#pragma unroll
    for (int a = 0; a < 2; ++a)
#pragma unroll
        for (int b = 0; b < 2; ++b)
#pragma unroll
            for (int m = 0; m < 4; ++m)
#pragma unroll
                for (int n = 0; n < 2; ++n) acc[a][b][m][n] = (f32x4){0.f, 0.f, 0.f, 0.f};
    bf16x8 At[4][2], B0[2][2], B1[2][2]; i32x8 At8[4], B08[2], B18[2];
    unsigned vgc[2][2], vgn[2][2];
#define PG8_GOFF(dst, u) do { _Pragma("unroll") for (int _h = 0; _h < 2; ++_h) _Pragma("unroll") for (int _i = 0; _i < 2; ++_i) { int Rr, C; stage_rc(tid * 16 + _i * 8192, Rr, C); \
        dst[_h][_i] = (unsigned)((size_t)S.arow(u, _h * HALF + Rr) * (size_t)K * ES + C * 2); } } while (0)
#define PG8_STA(b, h, PTR, NEXTSEL) do { if constexpr (Sched::GATHER) { if (NEXTSEL) PG8_STAGE(PG8_SA(b, h), PTR, vgn[h]); else PG8_STAGE(PG8_SA(b, h), PTR, vgc[h]); } \
        else PG8_STAGE(PG8_SA(b, h), (PTR) + (h) * hstep, voffA); } while (0)
    const char* cA = Sched::GATHER ? (const char*)A : (const char*)A + (size_t)cur.a0 * rstep; const char* cB = (const char*)Bt + (size_t)cur.b0 * rstep;
    if constexpr (Sched::GATHER) { PG8_GOFF(vgc, cur); }
    const int ntm = nt - 1;
#define PG8_KT(u, t) ((size_t)(((t) + (u).rot) & ntm) * kstep)
#define PG8_KTB(u, t) ((size_t)(((t) + (u).rot) & ntm) * kstepB)
    PG8_STAGE(PG8_SB(0, 0), cB + PG8_KTB(cur, 0), voffB); PG8_STA(0, 0, cA + PG8_KT(cur, 0), false); PG8_STAGE(PG8_SB(0, 1), cB + hstepB + PG8_KTB(cur, 0), voffB); PG8_STA(0, 1, cA + PG8_KT(cur, 0), false);
    if (wr == 1) PG8_BAR;
    PG8_WAIT_V(4); PG8_BAR;
    PG8_STAGE(PG8_SB(1, 0), cB + PG8_KTB(cur, 1), voffB); PG8_STA(1, 0, cA + PG8_KT(cur, 1), false); PG8_STAGE(PG8_SB(1, 1), cB + hstepB + PG8_KTB(cur, 1), voffB);
    PG8_WAIT_V(6); PG8_BAR;
    const PF pf = E.prefetch(cur, tid);
    for (;;) {
        const bool has_next = S.next(ui + 1, nxt);
        const char* nA = Sched::GATHER ? cA : (has_next ? (const char*)A + (size_t)nxt.a0 * rstep : cA); const char* nB = has_next ? (const char*)Bt + (size_t)nxt.b0 * rstep : cB;
        if constexpr (Sched::GATHER) { if (has_next) { PG8_GOFF(vgn, nxt); } else {
#pragma unroll
            for (int _h = 0; _h < 2; ++_h) { vgn[_h][0] = vgc[_h][0]; vgn[_h][1] = vgc[_h][1]; } }
            asm volatile("" : "+v"(vgn[0][0]), "+v"(vgn[0][1]), "+v"(vgn[1][0]), "+v"(vgn[1][1])); }
        for (int t = 0; t < nt; t += 2) {
            const bool last = (t == nt - 2);
            const Unit& un = has_next ? nxt : cur;
            const char* a1 = cA + PG8_KT(cur, t + 1); const char* b1 = cB + PG8_KTB(cur, t + 1);
            const char* a2 = last ? nA + PG8_KT(un, 0) : cA + PG8_KT(cur, t + 2); const char* b2 = last ? nB + PG8_KTB(un, 0) : cB + PG8_KTB(cur, t + 2);
            const char* a3 = last ? nA + PG8_KT(un, 1) : cA + PG8_KT(cur, t + 3); const char* b3 = last ? nB + PG8_KTB(un, 1) : cB + PG8_KTB(cur, t + 3); (void)b1;
            PG8_LDB(B0, 0, 0); PG8_SCHED; PG8_LDA(At, 0, 0); PG8_STA(1, 1, a1, false);
            PG8_WAIT_L(8); PG8_BAR; PG8_WAIT_L(0); PG8_MMA(0, 0, At, B0); PG8_BAR; PG8_SCHED;
            PG8_LDB(B1, 0, 1); PG8_STAGE(PG8_SB(0, 0), b2, voffB);
            PG8_BAR; PG8_WAIT_L(0); PG8_MMA(0, 1, At, B1); PG8_BAR;
            PG8_LDA(At, 0, 1); PG8_STA(0, 0, a2, last);
            PG8_BAR; PG8_WAIT_L(0); PG8_MMA(1, 0, At, B0); PG8_BAR; PG8_SCHED;
            PG8_STAGE(PG8_SB(0, 1), b2 + hstepB, voffB);
            PG8_WAIT_V(6); PG8_BAR; PG8_MMA(1, 1, At, B1); PG8_BAR;
            PG8_LDB(B0, 1, 0); PG8_SCHED; PG8_LDA(At, 1, 0); PG8_STA(0, 1, a2, last);
            PG8_WAIT_L(8); PG8_BAR; PG8_WAIT_L(0); PG8_MMA(0, 0, At, B0); PG8_BAR; PG8_SCHED;
            PG8_LDB(B1, 1, 1); PG8_STAGE(PG8_SB(1, 0), b3, voffB);
            PG8_BAR; PG8_WAIT_L(0); PG8_MMA(0, 1, At, B1); PG8_BAR;
            PG8_LDA(At, 1, 1); PG8_STA(1, 0, a3, last);
            PG8_BAR; PG8_WAIT_L(0); PG8_MMA(1, 0, At, B0); PG8_BAR; PG8_SCHED;
            PG8_STAGE(PG8_SB(1, 1), b3 + hstepB, voffB);
            PG8_WAIT_V(6); PG8_BAR; PG8_MMA(1, 1, At, B1); PG8_BAR;
        }
        asm volatile("" :: "v"(pf.a), "v"(pf.b), "v"(pf.c), "v"(pf.d));
        if constexpr (ES == 1) asm volatile("s_nop 15\n\ts_nop 15" ::: "memory");
        E(acc, cur, wr, wc, fr, fq);
        if (!has_next) break;
        if (!E.keep(cur)) {
#pragma unroll
        for (int a = 0; a < 2; ++a)
#pragma unroll
            for (int b = 0; b < 2; ++b)
#pragma unroll
                for (int m = 0; m < 4; ++m)
#pragma unroll
                    for (int n = 0; n < 2; ++n) acc[a][b][m][n] = (f32x4){0.f, 0.f, 0.f, 0.f}; }
        cur = nxt; cA = nA; cB = nB; ++ui;
        if constexpr (Sched::GATHER) {
#pragma unroll
            for (int _h = 0; _h < 2; ++_h) { vgc[_h][0] = vgn[_h][0]; vgc[_h][1] = vgn[_h][1]; } }
    }
    PG8_WAIT_V(0);
    if (wr == 0) PG8_BAR;
    PG8_BAR;
#undef PG8_SA
#undef PG8_LD32
#undef PG8_KT
#undef PG8_KTB
#undef PG8_GOFF
#undef PG8_STA
#undef PG8_SB
#undef PG8_STAGE
#undef PG8_LDA
#undef PG8_LDB
#undef PG8_MMA
#undef PG8_WAIT_V
#undef PG8_WAIT_L
#undef PG8_BAR
#undef PG8_SCHED
}
}

struct SchedProj { static constexpr bool BTILED = false; static constexpr bool GATHER = false; pg8::TileOrder T;
    __device__ int arow(const pg8::Unit&, int) const { return 0; }
    __device__ bool next(int i, pg8::Unit& u) const { int pm, pn; if (!T.tile(i, pm, pn)) return false; u.a0 = tok2prow(pm * 256); u.b0 = pn * 256; u.r0 = u.a0; u.c0 = pn * 256; u.aux = 0; u.nv = 256; u.rot = 0; return true; } };
struct EpiProj { __device__ __forceinline__ pg8::PF prefetch(const pg8::Unit&, int) const { return pg8::PF{0u, 0u, 0u, 0u}; } __device__ __forceinline__ bool keep(const pg8::Unit&) const { return false; } static constexpr bool PERM = true; bf16_t* P; const float* bias; float scale;
    __device__ __forceinline__ void operator()(f32x4 (&acc)[2][2][4][2], const pg8::Unit& u, int wr, int wc, int fr, int fq) const {
        const int row0 = u.r0 + wr * 64 + fr, col0 = u.c0 + wc * 32 + 8 * fq; const bool sig = u.c0 >= 6144;
        f32x4 bv[2][2];
#pragma unroll
        for (int bj = 0; bj < 2; ++bj)
#pragma unroll
            for (int n = 0; n < 2; ++n) bv[bj][n] = sig ? *(const f32x4*)(bias + col0 + bj * 128 + 4 * n) : (f32x4){0.f, 0.f, 0.f, 0.f};
#pragma unroll
        for (int ai = 0; ai < 2; ++ai)
#pragma unroll
            for (int m = 0; m < 4; ++m) { bf16_t* rowp = P + (size_t)(row0 + ai * 128 + m * 16) * NPROJ + col0;
#pragma unroll
                for (int bj = 0; bj < 2; ++bj) { f32x4 v0 = acc[ai][bj][m][0] * scale + bv[bj][0], v1 = acc[ai][bj][m][1] * scale + bv[bj][1];
                    if (sig) {
#pragma unroll
                        for (int j = 0; j < 4; ++j) { v0[j] = __builtin_amdgcn_rcpf(1.0f + __expf(-v0[j])); v1[j] = __builtin_amdgcn_rcpf(1.0f + __expf(-v1[j])); } }
                    u32x4 w; w.x = cvt_pk_bf16(v0[0], v0[1]); w.y = cvt_pk_bf16(v0[2], v0[3]); w.z = cvt_pk_bf16(v1[0], v1[1]); w.w = cvt_pk_bf16(v1[2], v1[3]);
                    *(u32x4*)(rowp + bj * 128) = w; } }
    }
};


struct SchedGate8 { static constexpr bool BTILED = true; static constexpr bool GATHER = false; pg8::TileOrder T;
    __device__ bool next(int i, pg8::Unit& u) const { int pm, pn; if (!T.tile(i, pm, pn)) return false; u.a0 = tok2prow(pm * 256); u.b0 = pn * 256; u.r0 = u.a0; u.c0 = 6144 + pn * 256; u.aux = 0; u.nv = 256; u.rot = 0; return true; }
    __device__ int arow(const pg8::Unit&, int) const { return 0; } };

__device__ __forceinline__ void proj_meta(const Params& p, const int task, float* red) {
    const int tid = otid(), wid = tid >> 6, lane = tid & 63, r16 = lane & 15, g = lane >> 4, c0 = 1024 + task * 32;
    const bf16_t* ap = p.XN() + (size_t)(PADF + r16) * D + wid * 256 + 8 * g;
    const bf16_t* bp0 = p.WinT() + (size_t)(c0 + r16) * D + wid * 256 + 8 * g; const bf16_t* bp1 = bp0 + (size_t)16 * D;
    bf16x8 a[8], b0[8], b1[8];
#pragma unroll
    for (int ks = 0; ks < 8; ++ks) { a[ks] = *reinterpret_cast<const bf16x8*>(ap + ks * 32); b0[ks] = *reinterpret_cast<const bf16x8*>(bp0 + ks * 32); b1[ks] = *reinterpret_cast<const bf16x8*>(bp1 + ks * 32); }
    f32x4 acc0 = {0.f, 0.f, 0.f, 0.f}, acc1 = {0.f, 0.f, 0.f, 0.f};
#pragma unroll
    for (int ks = 0; ks < 8; ++ks) { acc0 = __builtin_amdgcn_mfma_f32_16x16x32_bf16(a[ks], b0[ks], acc0, 0, 0, 0); acc1 = __builtin_amdgcn_mfma_f32_16x16x32_bf16(a[ks], b1[ks], acc1, 0, 0, 0); }
    *(f32x4*)(red + ((wid * 2 + 0) * 64 + lane) * 4) = acc0; *(f32x4*)(red + ((wid * 2 + 1) * 64 + lane) * 4) = acc1;
    __syncthreads();
    { const int l2 = tid & 63, blk = (tid >> 6) & 1, reg = tid >> 7; float v = 0.f;
#pragma unroll
      for (int w = 0; w < 8; ++w) v += red[((w * 2 + blk) * 64 + l2) * 4 + reg];
      const int row = PADF + 4 * (l2 >> 4) + reg, col = c0 + 16 * blk + (l2 & 15); const bf16_t o = (bf16_t)(cvt_pk_bf16(v, 0.f) & 0xffffu);
#pragma unroll
      for (int b = 0; b < NB; ++b) p.P()[(size_t)(b * LP + row) * NPROJ + col] = o; }
    __syncthreads();
}

struct CvtTile { const float* src; bf16_t* dst; int ld, K, f8; };
constexpr int CVT_NT = 1536 + 1024 + 512 + 512 + 32768 + 16384;
__device__ __forceinline__ CvtTile cvt_desc(const Params& p, int t) {
    CvtTile d;
    if (t < 1536) { const int nt = t / 16, kt = t % 16; d.src = p.w_in + (size_t)kt * 128 * INC + nt * 64; d.dst = p.WinT() + (size_t)(nt * 64) * 2048 + kt * 128; d.ld = INC; d.K = 2048; d.f8 = 0; return d; }
    t -= 1536;
    if (t < 1024) { const int nt = t / 16, kt = t % 16; d.src = p.w_gate + (size_t)kt * 128 * 4096 + nt * 64; d.dst = (bf16_t*)(p.WG8T() + ((size_t)(nt >> 2) * 16 + kt) * 32768 + (nt & 3) * 8192); d.ld = 4096; d.K = 128; d.f8 = 1; return d; }
    t -= 1024;
    if (t < 512) { const int which = t / 256, t2 = t % 256, nt = t2 / 8, kt = t2 % 8; d.src = (which ? p.w_bm : p.w_bda) + (size_t)kt * 128 * 2048 + nt * 64; d.dst = p.WbrT() + (size_t)(which * 2048 + nt * 64) * 1024 + kt * 128; d.ld = 2048; d.K = 1024; d.f8 = 0; return d; }
    t -= 512;
    if (t < 512) { const int nt = t / 16, kt = t % 16; d.src = p.w_out + (size_t)kt * 128 * 2048 + nt * 64; d.dst = (bf16_t*)((unsigned char*)p.WoutT() + ((size_t)(nt >> 2) * 16 + kt) * 32768 + (nt & 3) * 8192); d.ld = 2048; d.K = 128; d.f8 = 1; return d; }
    t -= 512;
    if (t < 32768) { const int e = t / 1024, t2 = t % 1024, nt = t2 / 16, kt = t2 % 16, blk = nt / 4, w0 = (nt % 4) * 64; const int scol = w0 < 128 ? blk * 128 + w0 : 2048 + blk * 128 + (w0 - 128);
        d.src = p.w1 + (size_t)e * 2048 * 4096 + (size_t)kt * 128 * 4096 + scol; d.dst = (bf16_t*)((unsigned char*)p.W1T() + ((size_t)(e * 16 + (nt >> 2)) * 16 + kt) * 32768 + (nt & 3) * 8192); d.ld = 4096; d.K = 128; d.f8 = 1; return d; }
    t -= 32768;
    { const int e = t / 512, t2 = t % 512, nt = t2 / 16, kt = t2 % 16; d.src = p.w2 + (size_t)e * 2048 * 2048 + (size_t)kt * 128 * 2048 + nt * 64; d.dst = (bf16_t*)((unsigned char*)p.W2T() + ((size_t)(e * 8 + (nt >> 2)) * 16 + kt) * 32768 + (nt & 3) * 8192); d.ld = 2048; d.K = 128; d.f8 = 1; return d; }
}

__device__ __forceinline__ CvtTile cvt_moe(const Params& p, int u, const int j) {
    CvtTile d; d.K = 128; d.f8 = 1;
    if (u < 8192) { const int c = u & 15, kt = (u >> 4) & 15, e = u >> 8, blk = 2 * (c & 7) + (j >> 1), nt = blk * 4 + (j & 1) + (c >= 8 ? 2 : 0);
        d.src = p.w1 + (size_t)e * 2048 * 4096 + (size_t)kt * 128 * 4096 + c * 256 + j * 64; d.dst = (bf16_t*)((unsigned char*)p.W1T() + ((size_t)(e * 16 + (nt >> 2)) * 16 + kt) * 32768 + (nt & 3) * 8192); d.ld = 4096; return d; }
    u -= 8192;
    { const int c = u & 7, kt = (u >> 3) & 15, e = u >> 7, nt = c * 4 + j;
        d.src = p.w2 + (size_t)e * 2048 * 2048 + (size_t)kt * 128 * 2048 + nt * 64; d.dst = (bf16_t*)((unsigned char*)p.W2T() + ((size_t)(e * 8 + (nt >> 2)) * 16 + kt) * 32768 + (nt & 3) * 8192); d.ld = 2048; return d; }
}
__device__ __forceinline__ void convert_ring(const Params& p, unsigned char* lds_, const int first, const int stride) {
    LAS unsigned char* lds = (LAS unsigned char*)lds_;
    const int tid = otid(), wid = __builtin_amdgcn_readfirstlane(tid >> 6), lk = tid >> 4, lq = tid & 15;
    constexpr int NSUP = 8192 + 4096;
    const int ntile = 4 * ((NSUP - first + stride - 1) / stride);
#define RING_ISSUE(i_, slot_) do { const CvtTile d_ = cvt_moe(p, first + ((i_) >> 2) * stride, (i_) & 3); _Pragma("unroll") for (int r_ = 0; r_ < 4; ++r_) { const int k_ = lk + 32 * r_; \
        __builtin_amdgcn_global_load_lds((const unsigned*)(d_.src + (size_t)k_ * d_.ld + ((lq ^ ((k_ >> 4) & 7)) << 2)), (LAS unsigned*)(lds + (slot_) * 32768 + (wid * 4 + 32 * r_) * 256), 16, 0, 2  ); } } while (0)
    if (ntile > 0) RING_ISSUE(0, 0);
    if (ntile > 1) RING_ISSUE(1, 1);
    if (ntile > 2) RING_ISSUE(2, 2);
    const int n = tid >> 3, kc = tid & 7;
    for (int it = 0; it < ntile; ++it) {
        if (it + 3 < ntile) { RING_ISSUE(it + 3, (it + 3) & 3); asm volatile("s_waitcnt vmcnt(12)" ::: "memory"); }
        else asm volatile("s_waitcnt vmcnt(0)" ::: "memory");
        __builtin_amdgcn_s_barrier();
        const CvtTile d = cvt_moe(p, first + (it >> 2) * stride, it & 3);
        const LAS float* qq = (const LAS float*)(lds + (it & 3) * 32768) + (kc * 16) * 64 + ((((n >> 2) ^ kc) << 2) | (n & 3));
        float v[16];
#pragma unroll
        for (int j = 0; j < 16; ++j) v[j] = qq[j * 64];
        asm volatile("s_waitcnt lgkmcnt(0)" ::: "memory");
        __builtin_amdgcn_s_barrier();
        u32x4 w; w.x = pk4_fp8(v[0] * W8_SCALE, v[1] * W8_SCALE, v[2] * W8_SCALE, v[3] * W8_SCALE); w.y = pk4_fp8(v[4] * W8_SCALE, v[5] * W8_SCALE, v[6] * W8_SCALE, v[7] * W8_SCALE);
        w.z = pk4_fp8(v[8] * W8_SCALE, v[9] * W8_SCALE, v[10] * W8_SCALE, v[11] * W8_SCALE); w.w = pk4_fp8(v[12] * W8_SCALE, v[13] * W8_SCALE, v[14] * W8_SCALE, v[15] * W8_SCALE);
        __builtin_nontemporal_store(w, (u32x4*)((unsigned char*)d.dst + (size_t)n * d.K + kc * 16));
    }
    asm volatile("s_waitcnt vmcnt(0)" ::: "memory");
#undef RING_ISSUE
}
__device__ __forceinline__ void phase0(const Params& p, unsigned char* lds) {
    const int tid = otid(), wid = tid >> 6, lane = tid & 63;
    {
        float* WgT = (float*)lds;
        for (int i = tid; i < 2048 * 4; i += 512) { const int k = i >> 2, q = i & 3; const float4 w4 = *(const float4*)(p.w_in + (size_t)k * INC + 6144 + q * 4);
            WgT[(q * 4 + 0) * 2048 + k] = w4.x; WgT[(q * 4 + 1) * 2048 + k] = w4.y; WgT[(q * 4 + 2) * 2048 + k] = w4.z; WgT[(q * 4 + 3) * 2048 + k] = w4.w; }
        for (int i = blockIdx.x * 512 + tid; i < NPROJ; i += gridDim.x * 512) p.biasP()[i] = i < 6144 ? 0.f : p.b_gate[i - 6144];
        __syncthreads();
        const int rstride = gridDim.x * 8; float4 vn[8];
#define P0_SRC(rr) (((rr) % LP) >= PADF + NMETA ? p.x + ((size_t)((rr) / LP) * SEQ + (((rr) % LP) - PADF - NMETA)) * D : p.meta + (size_t)(((rr) % LP) - PADF) * D)
        { const int r0 = blockIdx.x * 8 + wid; if (r0 < R && (r0 % LP) >= PADF) { const float* s0 = P0_SRC(r0);
#pragma unroll
            for (int q = 0; q < 8; ++q) vn[q] = *(const float4*)(s0 + q * 256 + lane * 4); } }
        for (int r = blockIdx.x * 8 + wid; r < R; r += rstride) {
            const int pp = r % LP;
            float4 v[8]; float ss = 0.f;
#pragma unroll
            for (int q = 0; q < 8; ++q) v[q] = vn[q];
            { const int rn = r + rstride; if (rn < R && (rn % LP) >= PADF) { const float* s1 = P0_SRC(rn);
#pragma unroll
                for (int q = 0; q < 8; ++q) vn[q] = *(const float4*)(s1 + q * 256 + lane * 4); } }
            if (pp < PADF) {
#pragma unroll
                for (int q = 0; q < 8; ++q) { *(u32x2*)(p.XN() + (size_t)r * D + q * 256 + lane * 4) = (u32x2){0u, 0u}; *(unsigned*)(p.XN8() + (size_t)r * D + q * 256 + lane * 4) = 0u; }
                if (lane < 16) p.gates()[(size_t)r * 16 + lane] = 0.f;
                continue; }
#pragma unroll
            for (int q = 0; q < 8; ++q) ss += v[q].x * v[q].x + v[q].y * v[q].y + v[q].z * v[q].z + v[q].w * v[q].w;
            ss = wave_sum(ss); const float rs = rsqrtf(ss / D + EPS);
            float ga[16];
#pragma unroll
            for (int g = 0; g < 16; ++g) ga[g] = 0.f;
#pragma unroll
            for (int q = 0; q < 8; ++q) { const int c = q * 256 + lane * 4; const float4 gn = *(const float4*)(p.norm_mix + c);
                const float x0 = v[q].x * rs * gn.x, x1 = v[q].y * rs * gn.y, x2 = v[q].z * rs * gn.z, x3 = v[q].w * rs * gn.w;
                u32x2 w; w.x = cvt_pk_bf16(x0, x1); w.y = cvt_pk_bf16(x2, x3); *(u32x2*)(p.XN() + (size_t)r * D + c) = w; *(unsigned*)(p.XN8() + (size_t)r * D + c) = pk4_fp8(x0, x1, x2, x3);
#pragma unroll
                for (int g = 0; g < 16; ++g) { const float4 w4 = *(const float4*)(WgT + g * 2048 + c); ga[g] += x0 * w4.x + x1 * w4.y + x2 * w4.z + x3 * w4.w; } }
            float a8[8], a4[4], a2[2];
            { const bool hb = (lane >> 5) & 1;
#pragma unroll
              for (int i = 0; i < 8; ++i) { const float x = hb ? ga[i + 8] : ga[i], y = hb ? ga[i] : ga[i + 8]; a8[i] = x + __shfl_xor(y, 32); } }
            { const bool hb = (lane >> 4) & 1;
#pragma unroll
              for (int i = 0; i < 4; ++i) { const float x = hb ? a8[i + 4] : a8[i], y = hb ? a8[i] : a8[i + 4]; a4[i] = x + __shfl_xor(y, 16); } }
            { const bool hb = (lane >> 3) & 1;
#pragma unroll
              for (int i = 0; i < 2; ++i) { const float x = hb ? a4[i + 2] : a4[i], y = hb ? a4[i] : a4[i + 2]; a2[i] = x + __shfl_xor(y, 8); } }
            float a1; { const bool hb = (lane >> 2) & 1; const float x = hb ? a2[1] : a2[0], y = hb ? a2[0] : a2[1]; a1 = x + __shfl_xor(y, 4); }
            a1 += __shfl_xor(a1, 2); a1 += __shfl_xor(a1, 1);
            if ((lane & 3) == 0) p.gates()[(size_t)r * 16 + (lane >> 2)] = a1;
        }
#undef P0_SRC
        __syncthreads();
    }
    {
        float* T = (float*)lds;
        const int lk = tid >> 4, lq = tid & 15;
        f32x4 cur[4][4], nxt[4][4];
#define CVT_LOAD(buf, g) do { _Pragma("unroll") for (int q = 0; q < 4; ++q) { const CvtTile d = cvt_desc(p, (g) * 4 + q); _Pragma("unroll") for (int i = 0; i < 4; ++i) \
            buf[q][i] = __builtin_nontemporal_load((const f32x4*)(d.src + (size_t)(lk + 32 * i) * d.ld + lq * 4)); } } while (0)
        int g = blockIdx.x;
        constexpr int G_HI = P1_WORKERS == NWG ? CVT_NT / 4 : (1536 + 1024 + 512 + 512) / 4;
        if (g < G_HI) CVT_LOAD(cur, g);
        for (; g < G_HI; g += gridDim.x) {
            const int gn = g + gridDim.x;
            if (gn < G_HI) CVT_LOAD(nxt, gn);
#pragma unroll
            for (int q = 0; q < 4; ++q)
#pragma unroll
                for (int i = 0; i < 4; ++i) { float* q0 = T + q * (128 * 65) + (lk + 32 * i) * 65 + lq * 4; q0[0] = cur[q][i][0]; q0[1] = cur[q][i][1]; q0[2] = cur[q][i][2]; q0[3] = cur[q][i][3]; }
            __syncthreads();
#pragma unroll
            for (int q = 0; q < 4; ++q) { const CvtTile d = cvt_desc(p, g * 4 + q);
                if (d.f8) { const int n = tid >> 3, kc = tid & 7; const float* qq = T + q * (128 * 65) + (kc * 16) * 65 + n; u32x4 w;
                    w.x = pk4_fp8(qq[0] * W8_SCALE, qq[65] * W8_SCALE, qq[130] * W8_SCALE, qq[195] * W8_SCALE); w.y = pk4_fp8(qq[260] * W8_SCALE, qq[325] * W8_SCALE, qq[390] * W8_SCALE, qq[455] * W8_SCALE);
                    w.z = pk4_fp8(qq[520] * W8_SCALE, qq[585] * W8_SCALE, qq[650] * W8_SCALE, qq[715] * W8_SCALE); w.w = pk4_fp8(qq[780] * W8_SCALE, qq[845] * W8_SCALE, qq[910] * W8_SCALE, qq[975] * W8_SCALE);
                    __builtin_nontemporal_store(w, (u32x4*)((unsigned char*)d.dst + (size_t)n * d.K + kc * 16));
                } else {
#pragma unroll
                for (int i = 0; i < 2; ++i) { const int ch = tid + 512 * i, n = ch >> 4, kc = ch & 15; const float* qq = T + q * (128 * 65) + (kc * 8) * 65 + n;
                    u32x4 w; w.x = cvt_pk_bf16(qq[0], qq[65]); w.y = cvt_pk_bf16(qq[130], qq[195]); w.z = cvt_pk_bf16(qq[260], qq[325]); w.w = cvt_pk_bf16(qq[390], qq[455]);
                    if (g >= 384) __builtin_nontemporal_store(w, (u32x4*)(d.dst + (size_t)n * d.K + kc * 8)); else *(u32x4*)(d.dst + (size_t)n * d.K + kc * 8) = w; } } }
            __syncthreads();
#pragma unroll
            for (int q = 0; q < 4; ++q)
#pragma unroll
                for (int i = 0; i < 4; ++i) cur[q][i] = nxt[q][i];
        }
#undef CVT_LOAD
    }
}


namespace att {
constexpr int QBLK = 32, KVBLK = 64, NW = 8;
constexpr float SCALE = 0.088388347648318440f, THR = 8.f;
constexpr int LDQ = NPROJ, LDK = NPROJ;
constexpr int SHM_V = KVBLK * 128 * 2, SHM_K = KVBLK * 128 * 2, SHM_ATTN = 2 * SHM_V + 2 * SHM_K + NW * 64 * 4;
constexpr int TAB_B = SHM_ATTN;
constexpr int O1_OFF = TAB_B + 1024;
using s16x4 = __attribute__((ext_vector_type(4))) short;
using f32x16 = __attribute__((ext_vector_type(16))) float;
#define KSWZ(row, colB) ((row) * 256 + ((colB) ^ (((row) & 7) << 4)))
#define SBAR() __builtin_amdgcn_sched_barrier(0)
__device__ __forceinline__ int crow(int r, int hi) { return (r & 3) + 8 * (r >> 2) + 4 * hi; }
__device__ __forceinline__ void partialSM(f32x16& p0, f32x16& p1, float& m_reg, float& mn, float& alpha, const float cadd) {
  constexpr float C = SCALE * 1.4426950408889634f;
  float pmax = p0[0]; for (int r = 1; r < 16; ++r) pmax = fmaxf(pmax, p0[r]); for (int r = 0; r < 16; ++r) pmax = fmaxf(pmax, p1[r]);
  { auto rr = __builtin_amdgcn_permlane32_swap(__float_as_uint(pmax), __float_as_uint(pmax), false, false);
    pmax = fmaxf(__uint_as_float(rr[0]), __uint_as_float(rr[1])); }
  pmax += cadd;
  if (__builtin_expect(__all(pmax - m_reg <= THR / SCALE), 1)) { mn = m_reg; alpha = 1.f; }
  else { mn = fmaxf(m_reg, pmax); alpha = __builtin_amdgcn_exp2f((m_reg - mn) * C); m_reg = mn; }
  float mnC = (cadd - mn) * C;
  for (int r = 0; r < 16; ++r) p0[r] = fmaf(p0[r], C, mnC); for (int r = 0; r < 16; ++r) p1[r] = fmaf(p1[r], C, mnC);
  for (int r = 0; r < 16; ++r) p0[r] = __builtin_amdgcn_exp2f(p0[r]);
}
__device__ __forceinline__ void finishSM(f32x16& p0, f32x16& p1, float alpha, float& l_reg, bf16x8& pa0, bf16x8& pa1, bf16x8& pa2, bf16x8& pa3) {
  for (int r = 0; r < 16; ++r) p1[r] = __builtin_amdgcn_exp2f(p1[r]);
  float ps = 0; for (int r = 0; r < 16; ++r) ps += p0[r]; for (int r = 0; r < 16; ++r) ps += p1[r];
  { auto rr = __builtin_amdgcn_permlane32_swap(__float_as_uint(ps), __float_as_uint(ps), false, false);
    ps = __uint_as_float(rr[0]) + __uint_as_float(rr[1]); }
  l_reg = l_reg * alpha + ps;
#define PK4(P, BASE, OUT) do { unsigned a0 = cvt_pk_bf16(P[BASE + 0], P[BASE + 1]), a1 = cvt_pk_bf16(P[BASE + 2], P[BASE + 3]);   \
    unsigned b0 = cvt_pk_bf16(P[BASE + 4], P[BASE + 5]), b1 = cvt_pk_bf16(P[BASE + 6], P[BASE + 7]);                              \
    auto r0 = __builtin_amdgcn_permlane32_swap(a0, b0, false, false); auto r1 = __builtin_amdgcn_permlane32_swap(a1, b1, false, false); \
    u32x4 w = {r0[0], r1[0], r0[1], r1[1]}; OUT = *reinterpret_cast<bf16x8*>(&w); } while (0)
  PK4(p0, 0, pa0); PK4(p0, 8, pa1); PK4(p1, 0, pa2); PK4(p1, 8, pa3);
#undef PK4
}
__device__ __forceinline__ void qkt(f32x16& p0, f32x16& p1, const bf16_t* Ks, const bf16x8* qr, int r32, int hi) {
  p0 = f32x16{}; p1 = f32x16{};
  for (int d0 = 0; d0 < 8; ++d0) { int cb = (d0 * 16 + hi * 8) * 2;
    bf16x8 b0 = *reinterpret_cast<const bf16x8*>((const char*)Ks + KSWZ(r32, cb));
    bf16x8 b1 = *reinterpret_cast<const bf16x8*>((const char*)Ks + KSWZ(32 + r32, cb));
    p0 = __builtin_amdgcn_mfma_f32_32x32x16_bf16(b0, qr[d0], p0, 0, 0, 0);
    p1 = __builtin_amdgcn_mfma_f32_32x32x16_bf16(b1, qr[d0], p1, 0, 0, 0); }
}
__device__ __forceinline__ int v_st(int k, int c) { const int kk = (k & ~0xC) | ((k & 4) << 1) | ((k & 8) >> 1); return ((kk >> 3) * 4 + (c >> 5)) * 512 + ((kk & 7) * 32 + (c & 31)) * 2; }
__device__ __forceinline__ int v_rd_base(int lane) { return ((lane & 3) << 3) | (((lane >> 2) & 3) << 6) | (((lane >> 4) & 1) << 5) | (((lane >> 5) & 1) << 8); }
constexpr int v_rd_off(int d0, int ks, int half) { return d0 * 512 + ks * 4096 + half * 2048; }
template <int OFF> __device__ __forceinline__ s16x4 tr_read(int vb) {
  s16x4 r; asm volatile("ds_read_b64_tr_b16 %0, %1 offset:%2" : "=&v"(r) : "v"(vb), "i"(OFF) : "memory"); return r;
}
template <int D0> __device__ __forceinline__ void pv_one(f32x16& od, int vb, bf16x8 pa0, bf16x8 pa1, bf16x8 pa2, bf16x8 pa3) {
  const s16x4 l0 = tr_read<v_rd_off(D0, 0, 0)>(vb), h0 = tr_read<v_rd_off(D0, 0, 1)>(vb), l1 = tr_read<v_rd_off(D0, 1, 0)>(vb), h1 = tr_read<v_rd_off(D0, 1, 1)>(vb);
  const s16x4 l2 = tr_read<v_rd_off(D0, 2, 0)>(vb), h2 = tr_read<v_rd_off(D0, 2, 1)>(vb), l3 = tr_read<v_rd_off(D0, 3, 0)>(vb), h3 = tr_read<v_rd_off(D0, 3, 1)>(vb);
  asm volatile("s_waitcnt lgkmcnt(0)" ::: "memory"); SBAR();
#define PK(L, H) (bf16x8){L[0], L[1], L[2], L[3], H[0], H[1], H[2], H[3]}
  od = __builtin_amdgcn_mfma_f32_32x32x16_bf16(pa0, PK(l0, h0), od, 0, 0, 0);
  od = __builtin_amdgcn_mfma_f32_32x32x16_bf16(pa1, PK(l1, h1), od, 0, 0, 0);
  od = __builtin_amdgcn_mfma_f32_32x32x16_bf16(pa2, PK(l2, h2), od, 0, 0, 0);
  od = __builtin_amdgcn_mfma_f32_32x32x16_bf16(pa3, PK(l3, h3), od, 0, 0, 0);
#undef PK
}
__device__ __forceinline__ void pv_d0(f32x16* o, int vb, bf16x8 pa0, bf16x8 pa1, bf16x8 pa2, bf16x8 pa3) {
  pv_one<0>(o[0], vb, pa0, pa1, pa2, pa3); pv_one<1>(o[1], vb, pa0, pa1, pa2, pa3); pv_one<2>(o[2], vb, pa0, pa1, pa2, pa3); pv_one<3>(o[3], vb, pa0, pa1, pa2, pa3);
}
__device__ __forceinline__ float tile_bias(f32x16& p0, f32x16& p1, const int kt, const int q0w, const int r32, const int hi, const float* tab) {
  const int k0 = kt * KVBLK;
  if (kt >= 2) { if (k0 + 63 - q0w <= -91) return tab[0]; if (k0 - (q0w + 31) >= 91) return tab[182]; }
  const int d0 = k0 + 4 * hi - (q0w + r32) + 91, m01 = kt <= 1 ? 183 : 0, m0 = kt == 0 ? 183 : 0;
#pragma unroll
  for (int r = 0; r < 16; ++r) { const int i0 = max(min(max(d0 + (r & 3) + 8 * (r >> 2), 0), 182), m01), i1 = max(min(max(d0 + 32 + (r & 3) + 8 * (r >> 2), 0), 182), r < 8 ? m01 : m0);
    p0[r] += tab[i0]; p1[r] += tab[i1]; }
  return 0.f;
}
__device__ __forceinline__ void attn_pass(const int PASS, const bf16_t* __restrict__ Qb, const bf16_t* __restrict__ Kh, const bf16_t* __restrict__ Vh, float* __restrict__ Ob, const int q0, char* lds) {
  int tid_ = threadIdx.x; asm volatile("" : "+v"(tid_));
  const int tid = tid_, wid = tid >> 6, lane = tid & 63, r32 = lane & 31, hi = lane >> 5;
  bf16_t* V_lds = (bf16_t*)lds; bf16_t* K_lds = (bf16_t*)(lds + 2 * SHM_V);
  float* ws = (float*)(lds + 2 * SHM_V + 2 * SHM_K) + wid * 64; float* li_l = ws; float* al_l = ws + 32;
  const float* tab = (const float*)(lds + TAB_B);
  const int q0w = q0 + wid * QBLK;
  float m_reg = -1e30f, l_reg = 0; f32x16 o[4] = {}; bf16x8 qr[8];
  const bf16_t* Qw = Qb + (long)(wid * QBLK + r32) * LDQ + hi * 8;
#pragma unroll
  for (int d0 = 0; d0 < 8; ++d0) qr[d0] = *reinterpret_cast<const bf16x8*>(Qw + d0 * 16);
  const int sr = tid >> 4, sc = (tid & 15) * 8, vst0 = v_st(sr, sc), vst1 = v_st(32 + sr, sc);
  const int vb0 = (int)(uintptr_t)V_lds + v_rd_base(lane);
  const unsigned loff = (unsigned)(sr * LDK + sc) * 2u;
  struct { bf16x8 vs0, vs1, ks0, ks1; } sr_[1];
#define SLOAD(i, k0) do { const char* vb_ = (const char*)Vh + (size_t)(k0) * (LDK * 2); const char* kb_ = (const char*)Kh + (size_t)(k0) * (LDK * 2); \
    sr_[i].vs0 = *reinterpret_cast<const bf16x8*>(vb_ + loff); sr_[i].vs1 = *reinterpret_cast<const bf16x8*>(vb_ + 32 * LDK * 2 + loff); \
    sr_[i].ks0 = *reinterpret_cast<const bf16x8*>(kb_ + loff); sr_[i].ks1 = *reinterpret_cast<const bf16x8*>(kb_ + 32 * LDK * 2 + loff); } while (0)
#define SWRITE(b, i) do { *(bf16x8*)((char*)V_lds + (b) * SHM_V + vst0) = sr_[i].vs0;          \
    *(bf16x8*)((char*)V_lds + (b) * SHM_V + vst1) = sr_[i].vs1; int kc = sc * 2;               \
    *(bf16x8*)((char*)K_lds + (b) * SHM_K + KSWZ(sr, kc)) = sr_[i].ks0;                       \
    *(bf16x8*)((char*)K_lds + (b) * SHM_K + KSWZ(32 + sr, kc)) = sr_[i].ks1; } while (0)
#define SWAIT() asm volatile("s_waitcnt vmcnt(0)" ::: "memory")
#define RESC(a) do { if (__any((a) < 1.f)) { if (hi == 0) al_l[r32] = (a); asm volatile("s_waitcnt lgkmcnt(0)" ::: "memory"); \
    for (int d = 0; d < 4; ++d) for (int r = 0; r < 16; ++r) o[d][r] *= al_l[crow(r, hi)]; } } while (0)
  f32x16 pA0, pA1, pB0, pB1; float mnA, mnB, alA, alB; bf16x8 pa0, pa1, pa2, pa3; int NT = LP / KVBLK; asm volatile("" : "+s"(NT));
  constexpr int SE = 0, SO = 0;
  SLOAD(SE, 0); asm volatile("s_waitcnt vmcnt(0)" ::: "memory"); SWRITE(0, SE); __syncthreads();
  qkt(pA0, pA1, K_lds, qr, r32, hi); { const float ca = tile_bias(pA0, pA1, 0, q0w, r32, hi, tab); partialSM(pA0, pA1, m_reg, mnA, alA, ca); }
  SLOAD(SO, KVBLK);
  SWAIT(); SWRITE(1, SO); __syncthreads();
  for (int j = 1; j + 1 < NT; j += 2) {
    SBAR(); qkt(pB0, pB1, (bf16_t*)((char*)K_lds + SHM_K), qr, r32, hi);
    finishSM(pA0, pA1, alA, l_reg, pa0, pa1, pa2, pa3); SBAR();
    SLOAD(SO, (j + 1) * KVBLK); SBAR();
    pv_d0(o, vb0, pa0, pa1, pa2, pa3); { const float cb = tile_bias(pB0, pB1, j, q0w, r32, hi, tab); partialSM(pB0, pB1, m_reg, mnB, alB, cb); }
    __syncthreads(); SWAIT(); SWRITE(0, SE);
    RESC(alB); __syncthreads();
    SBAR(); qkt(pA0, pA1, K_lds, qr, r32, hi);
    finishSM(pB0, pB1, alB, l_reg, pa0, pa1, pa2, pa3); SBAR();
    SLOAD(SE, (j + 2) * KVBLK); SBAR();
    pv_d0(o, vb0 + (int)SHM_V, pa0, pa1, pa2, pa3); { const float ca = tile_bias(pA0, pA1, j + 1, q0w, r32, hi, tab); partialSM(pA0, pA1, m_reg, mnA, alA, ca); }
    __syncthreads(); SWAIT(); SWRITE(1, SO);
    RESC(alA); __syncthreads();
  }
  SBAR(); qkt(pB0, pB1, (bf16_t*)((char*)K_lds + SHM_K), qr, r32, hi);
  finishSM(pA0, pA1, alA, l_reg, pa0, pa1, pa2, pa3); SBAR();
  pv_d0(o, vb0, pa0, pa1, pa2, pa3); { const float cb = tile_bias(pB0, pB1, NT - 1, q0w, r32, hi, tab); partialSM(pB0, pB1, m_reg, mnB, alB, cb); }
  __syncthreads(); RESC(alB);
  finishSM(pB0, pB1, alB, l_reg, pa0, pa1, pa2, pa3); SBAR();
  pv_d0(o, vb0 + (int)SHM_V, pa0, pa1, pa2, pa3);
  if (hi == 0) li_l[r32] = l_reg; asm volatile("s_waitcnt lgkmcnt(0)" ::: "memory");
  float rli[16];
#pragma unroll
  for (int r = 0; r < 16; ++r) rli[r] = __builtin_amdgcn_rcpf(li_l[crow(r, hi)]);
  const float lam = tab[184];
  bf16_t* O1w = (bf16_t*)(lds + O1_OFF) + (wid * QBLK) * 128 + r32;
  if (PASS == 0) {
#pragma unroll
    for (int r = 0; r < 16; ++r) { const int orow = crow(r, hi); const float f = rli[r];
#pragma unroll
      for (int d0 = 0; d0 < 4; ++d0) O1w[orow * 128 + d0 * 32] = (bf16_t)(cvt_pk_bf16(o[d0][r] * f, 0.f) & 0xffffu); }
  } else { float* Ow = Ob + (long)(wid * QBLK) * 1024 + r32;
#pragma unroll
    for (int r = 0; r < 16; ++r) { const int orow = crow(r, hi); const float f = rli[r] * lam;
#pragma unroll
      for (int d0 = 0; d0 < 4; ++d0) Ow[(long)orow * 1024 + d0 * 32] = bf2f(O1w[orow * 128 + d0 * 32]) - o[d0][r] * f; } }
  __syncthreads();
#undef SLOAD
#undef SWRITE
#undef SWAIT
#undef RESC
}
#undef KSWZ
#undef SBAR
}
__device__ __forceinline__ void phase_attn(const Params& p, unsigned char* lds_) {
    char* lds = (char*)lds_; float* tab = (float*)(lds + att::TAB_B);
    const int tid = otid();
    for (int it = blockIdx.x; it < 256; it += gridDim.x) {
        const int g = (it & 7) * 2 + ((it >> 3) >> 4), qb = (it >> 3) & 15, b = g >> 3, h = (g >> 1) & 3, dvh = g & 1;
        if (tid < 183) tab[tid] = p.rel_bias[t5_bucket(tid - 91) * 4 + h] * (1.0f / att::SCALE); else if (tid == 183) tab[183] = -1e30f;
        if (tid >= 448) { const int l = tid - 448; float a = p.lamp[l] * p.lamp[128 + l] + p.lamp[64 + l] * p.lamp[192 + l], c = p.lamp[256 + l] * p.lamp[384 + l] + p.lamp[320 + l] * p.lamp[448 + l];
            a = wave_sum(a); c = wave_sum(c); if (l == 0) tab[184] = __expf(a) - __expf(c) + 0.2f; }
        __syncthreads();
        const int q0 = PADF + NMETA + qb * 256;
        const bf16_t* Pb = p.P() + (size_t)b * LP * NPROJ;
        const size_t ooff = (size_t)(b * SEQ + qb * 256) * 1024 + h * 256 + dvh * 128;
#pragma unroll 1
        for (int pass = 0; pass < 2; ++pass)
            att::attn_pass(pass, Pb + (size_t)q0 * NPROJ + h * 256 + pass * 128, Pb + 1024 + h * 256 + pass * 128, Pb + 2048 + h * 256 + dvh * 128, p.OS() + ooff, q0, lds);
    }
}
__device__ __forceinline__ void phase_yda(const Params& p) {
    const int tid = otid(), wid = tid >> 6, lane = tid & 63;
    const float4 g = *(const float4*)(p.subln + lane * 4);
    static_assert((NTOK * 4) % (NWG * 8 * 4) == 0, "yda batches");
    for (int w0 = blockIdx.x * 8 + wid; w0 < NTOK * 4; w0 += gridDim.x * 8 * 4) {
        float4 v[4];
#pragma unroll
        for (int q = 0; q < 4; ++q) { const size_t o_ = (size_t)(w0 + q * gridDim.x * 8) * 256 + lane * 4; v[q] = *(const float4*)(p.OS() + o_); }
#pragma unroll
        for (int q = 0; q < 4; ++q) { const int w = w0 + q * gridDim.x * 8;
            const float ss = wave_sum(v[q].x * v[q].x + v[q].y * v[q].y + v[q].z * v[q].z + v[q].w * v[q].w); const float rs = rsqrtf(ss / 256.f + EPS) * 0.8f;
            u32x2 o; o.x = cvt_pk_bf16(v[q].x * rs * g.x, v[q].y * rs * g.y); o.y = cvt_pk_bf16(v[q].z * rs * g.z, v[q].w * rs * g.w);
            *(u32x2*)(p.YDM() + (size_t)w * 256 + lane * 4) = o; }
    }
}


namespace mls {
using att::f32x16; using att::s16x4; using att::crow; using att::v_st; using att::v_rd_base; using att::v_rd_off; using att::tr_read; using att::pv_d0;
constexpr int NCH = 33;
__device__ __forceinline__ bf16x8 scale8(bf16x8 v, float w) { const u32x4 u = *reinterpret_cast<u32x4*>(&v); u32x4 o;
    o.x = cvt_pk_bf16(bflo(u.x) * w, bfhi(u.x) * w); o.y = cvt_pk_bf16(bflo(u.y) * w, bfhi(u.y) * w); o.z = cvt_pk_bf16(bflo(u.z) * w, bfhi(u.z) * w); o.w = cvt_pk_bf16(bflo(u.w) * w, bfhi(u.w) * w);
    return *reinterpret_cast<bf16x8*>(&o); }
template <int NCT, bool SCALE>
__device__ __forceinline__ void stage_img(const bf16_t* src, const int ld, char* img, const float* wrow, const int tid) {
    const int sr = tid >> 4, sc = (tid & 15) * 8, o0 = v_st(sr, sc), o1 = v_st(32 + sr, sc);
#pragma unroll
    for (int ct = 0; ct < NCT; ++ct)
#pragma unroll
        for (int rt = 0; rt < 2; ++rt) { const bf16_t* s0 = src + (size_t)(rt * 64 + sr) * ld + ct * 128 + sc;
            bf16x8 v0 = *reinterpret_cast<const bf16x8*>(s0), v1 = *reinterpret_cast<const bf16x8*>(s0 + (size_t)32 * ld);
            if (SCALE) { v0 = scale8(v0, wrow[rt * 64 + sr]); v1 = scale8(v1, wrow[rt * 64 + 32 + sr]); }
            *reinterpret_cast<bf16x8*>(img + (ct * 2 + rt) * 16384 + o0) = v0; *reinterpret_cast<bf16x8*>(img + (ct * 2 + rt) * 16384 + o1) = v1; }
}
__device__ __forceinline__ void m0_conv_gates(const Params& p) {
    const int tid = otid(), wid = tid >> 6, lane = tid & 63;
    const bf16_t* P = p.P(); bf16_t* Qc = p.Qc(); bf16_t* Kc = p.Kc();
    {
        const int c8 = (tid & 127) * 8; const float sc = c8 < 512 ? 0.08838834764831845f : 1.0f;
        float4 w0[5], w1[5];
#pragma unroll
        for (int j = 0; j < 5; ++j) { w0[j] = *(const float4*)(p.conv_w + j * 1024 + c8); w1[j] = *(const float4*)(p.conv_w + j * 1024 + c8 + 4); }
        const int stride = gridDim.x * 512;
        for (int idx0 = blockIdx.x * 512 + tid; idx0 < R * 128; idx0 += 2 * stride) {
            u32x4 u[2][5];
#pragma unroll
            for (int q = 0; q < 2; ++q) { const int idx = idx0 + q * stride, r = idx >> 7, pp = r % LP;
#pragma unroll
                for (int j = 0; j < 5; ++j) { const int rr = r + j - 2, pin = pp + j - 2; u[q][j] = (u32x4){0u, 0u, 0u, 0u};
                    if (idx < R * 128 && pp >= PADF && pin >= PADF && pin < LP) u[q][j] = *(const u32x4*)(P + (size_t)rr * NPROJ + C_MQ + c8); } }
#pragma unroll
            for (int q = 0; q < 2; ++q) { const int idx = idx0 + q * stride, r = idx >> 7; if (idx >= R * 128) break;
                float acc[8];
#pragma unroll
                for (int j = 0; j < 8; ++j) acc[j] = 0.f;
#pragma unroll
                for (int j = 0; j < 5; ++j) { const u32x4 t = u[q][j];
                    acc[0] += w0[j].x * bflo(t.x); acc[1] += w0[j].y * bfhi(t.x); acc[2] += w0[j].z * bflo(t.y); acc[3] += w0[j].w * bfhi(t.y);
                    acc[4] += w1[j].x * bflo(t.z); acc[5] += w1[j].y * bfhi(t.z); acc[6] += w1[j].z * bflo(t.w); acc[7] += w1[j].w * bfhi(t.w); }
#pragma unroll
                for (int j = 0; j < 8; ++j) acc[j] = acc[j] * __builtin_amdgcn_rcpf(1.0f + __expf(-acc[j])) * sc;
                u32x4 o; o.x = cvt_pk_bf16(acc[0], acc[1]); o.y = cvt_pk_bf16(acc[2], acc[3]); o.z = cvt_pk_bf16(acc[4], acc[5]); o.w = cvt_pk_bf16(acc[6], acc[7]);
                if (c8 < 512) *(u32x4*)(Qc + (size_t)r * 512 + c8) = o; else *(u32x4*)(Kc + (size_t)r * 512 + (c8 - 512)) = o; }
        }
    }
    for (int task = blockIdx.x * 8 + wid; task < 16 * NCH; task += gridDim.x * 8) {
        const int seq = task / NCH, c = task % NCH, b = seq >> 3, h = (seq >> 1) & 3, dir = seq & 1;
        const float bi = p.gate_bias[(dir * 2) * 4 + h], bfb = p.gate_bias[(dir * 2 + 1) * 4 + h];
        float li[2], lf[2]; int tt[2];
#pragma unroll
        for (int q = 0; q < 2; ++q) { const int i = 2 * lane + q, t = dir ? 127 - i : i, pp = c * 128 + t; tt[q] = t;
            if (pp >= PADF) { const float* g = p.gates() + (size_t)(b * LP + pp) * 16; li[q] = g[(dir * 2) * 4 + h] + bi; lf[q] = logsigmoidf_(g[(dir * 2 + 1) * 4 + h] + bfb); }
            else { li[q] = -__builtin_inff(); lf[q] = 0.f; } }
        float s1 = lf[0] + lf[1], incl = s1;
#pragma unroll
        for (int o = 1; o < 64; o <<= 1) { const float t = __shfl_up(incl, o); if (lane >= o) incl += t; }
        const float b1 = incl, b0 = incl - lf[1];
        const float a0 = li[0] - b0, a1 = li[1] - b1;
        float pm = fmaxf(a0, a1), run = pm;
#pragma unroll
        for (int o = 1; o < 64; o <<= 1) { const float t = __shfl_up(run, o); if (lane >= o) run = fmaxf(run, t); }
        const float excl = __shfl_up(run, 1); const float pm0 = lane ? fmaxf(excl, a0) : a0, pm1 = run;
        float* GB = p.GB() + (size_t)seq * LP + c * 128; float* GA = p.GA() + (size_t)seq * LP + c * 128; float* GPM = p.GPM() + (size_t)seq * LP + c * 128;
        GB[tt[0]] = b0; GB[tt[1]] = b1; GA[tt[0]] = a0; GA[tt[1]] = a1; GPM[tt[0]] = pm0; GPM[tt[1]] = pm1;
        const float Atot = __shfl(run, 63), Btot = __shfl(incl, 63);
        if (lane == 0) { p.CS()[(seq * NCH + c) * 2] = Atot; p.CS()[(seq * NCH + c) * 2 + 1] = Btot; }
    }
}
__device__ __forceinline__ void m1_summaries(const Params& p, unsigned char* lds_) {
    char* lds = (char*)lds_; char* Vimg = lds; char* Kimg = lds + 65536; float* wrow = (float*)(lds + 98304);
    for (int it = blockIdx.x; it < 512; it += gridDim.x) {
        int tid_ = threadIdx.x; asm volatile("" : "+v"(tid_)); const int tid = tid_, wid = tid >> 6, lane = tid & 63, r32 = lane & 31, hi = lane >> 5;
        const int seq = it >> 5, k = it & 31, b = seq >> 3, h = (seq >> 1) & 3, dir = seq & 1, c = dir ? 32 - k : k;
        const int r0 = b * LP + c * 128;
        if (tid < 128) wrow[tid] = __expf(p.GA()[(size_t)seq * LP + c * 128 + tid] - p.CS()[(seq * NCH + c) * 2]);
        __syncthreads();
        stage_img<1, false>(p.Kc() + (size_t)r0 * 512 + h * 128, 512, Kimg, nullptr, tid);
        stage_img<2, true>(p.P() + (size_t)r0 * NPROJ + C_MV + h * 256, NPROJ, Vimg, wrow, tid);
        { float* red = wrow + 256; const int col = tid & 127, part = tid >> 7; float s = 0.f; const bf16_t* kp = p.Kc() + (size_t)(r0 + part * 32) * 512 + h * 128 + col;
#pragma unroll 8
          for (int q = 0; q < 32; ++q) s += wrow[part * 32 + q] * bf2f(kp[(size_t)q * 512]);
          red[part * 128 + col] = s; }
        __syncthreads();
        if (tid < 128) { const float* red = wrow + 256; p.DN()[((size_t)seq * NCH + c) * 128 + tid] = red[tid] + red[128 + tid] + red[256 + tid] + red[384 + tid]; }
        const int dkb = wid & 3, dvh = wid >> 2;
        f32x16 o[4] = {};
        const int vbV = (int)(uintptr_t)Vimg + v_rd_base(lane) + dvh * 32768, vbK = (int)(uintptr_t)Kimg + v_rd_base(lane) + dkb * 512;
#pragma unroll
        for (int rt = 0; rt < 2; ++rt) {
            const int kb = vbK + rt * 16384;
            const s16x4 l0 = tr_read<v_rd_off(0, 0, 0)>(kb), h0 = tr_read<v_rd_off(0, 0, 1)>(kb), l1 = tr_read<v_rd_off(0, 1, 0)>(kb), h1 = tr_read<v_rd_off(0, 1, 1)>(kb);
            const s16x4 l2 = tr_read<v_rd_off(0, 2, 0)>(kb), h2 = tr_read<v_rd_off(0, 2, 1)>(kb), l3 = tr_read<v_rd_off(0, 3, 0)>(kb), h3 = tr_read<v_rd_off(0, 3, 1)>(kb);
            asm volatile("s_waitcnt lgkmcnt(0)" ::: "memory"); __builtin_amdgcn_sched_barrier(0);
#define PK(L, H) (bf16x8){L[0], L[1], L[2], L[3], H[0], H[1], H[2], H[3]}
            pv_d0(o, vbV + rt * 16384, PK(l0, h0), PK(l1, h1), PK(l2, h2), PK(l3, h3));
#undef PK
        }
        float* dc = p.DC() + ((size_t)seq * NCH + c) * 32768;
#pragma unroll
        for (int r = 0; r < 16; ++r) { const int dk = dkb * 32 + crow(r, hi);
#pragma unroll
            for (int d0 = 0; d0 < 4; ++d0) dc[(size_t)dk * 256 + dvh * 128 + d0 * 32 + r32] = o[d0][r]; }
        __syncthreads();
    }
}
__device__ __forceinline__ void m2_scan(const Params& p) {
    const int gid = blockIdx.x * 512 + otid();
    for (int g = gid; g < 16 * 128 * 64; g += gridDim.x * 512) {
        const int seq = g >> 13, rem = g & 8191, dk = rem >> 6, dv4 = (rem & 63) * 4, dir = seq & 1;
        float4 C = make_float4(0.f, 0.f, 0.f, 0.f); float n = 0.f, m = 0.f;
        for (int k0 = 0; k0 < NCH; k0 += 16) {
            float4 d[16]; float dn[16]; float2 cs[16];
#pragma unroll
            for (int j = 0; j < 16; ++j) { const int k = k0 + j; if (k < NCH - 1) { const int c = dir ? 32 - k : k; const size_t sc = (size_t)seq * NCH + c;
                d[j] = *(const float4*)(p.DC() + sc * 32768 + (size_t)dk * 256 + dv4); dn[j] = dv4 == 0 ? p.DN()[sc * 128 + dk] : 0.f; cs[j] = *(const float2*)(p.CS() + sc * 2); } else { d[j] = make_float4(0.f, 0.f, 0.f, 0.f); dn[j] = 0.f; cs[j] = make_float2(0.f, 0.f); } }
#pragma unroll
            for (int j = 0; j < 16; ++j) { const int k = k0 + j; if (k < NCH) { const int c = dir ? 32 - k : k; const size_t sc = (size_t)seq * NCH + c;
                u32x2 w; w.x = cvt_pk_bf16(C.x, C.y); w.y = cvt_pk_bf16(C.z, C.w); *(u32x2*)(p.Cst() + sc * 32768 + (size_t)dk * 256 + dv4) = w;
                if (dv4 == 0) p.Nst()[sc * 128 + dk] = n; if (rem == 0) p.Mst()[sc] = m;
                if (k < NCH - 1) { const float A = cs[j].x, B = cs[j].y, Mx = fmaxf(m, A), wc = __expf(m - Mx), ws = __expf(A - Mx);
                    C.x = wc * C.x + ws * d[j].x; C.y = wc * C.y + ws * d[j].y; C.z = wc * C.z + ws * d[j].z; C.w = wc * C.w + ws * d[j].w;
                    n = wc * n + ws * dn[j]; m = B + Mx; } } }
        }
    }
}
#define KSWZ(row, colB) ((row) * 256 + ((colB) ^ (((row) & 7) << 4)))
__device__ __forceinline__ void m3_outputs(const Params& p, unsigned char* lds_) {
    char* lds = (char*)lds_; char* Vimg = lds; char* Cimg = lds + 65536; char* Kt = lds + 65536;
    float* tabA = (float*)(lds + 131072);
    float* tabN = tabA + 256;
    float* wsc = tabN + 128;
    for (int it = blockIdx.x; it < 256; it += gridDim.x) {
        int tid_ = threadIdx.x; asm volatile("" : "+v"(tid_)); const int tid = tid_, wid = tid >> 6, lane = tid & 63, r32 = lane & 31, hi = lane >> 5;
        float* ws = wsc + wid * 64;
        const int c = 1 + (it & 31), bh = it >> 5, b = bh >> 2, h = bh & 3, r0 = b * LP + c * 128, tt = wid & 3, dvh = wid >> 2, t = tt * 32 + r32;
        { const int sr = tid >> 4, sc = (tid & 15) * 8;
#pragma unroll
          for (int rt = 0; rt < 2; ++rt) { const bf16_t* s0 = p.Kc() + (size_t)(r0 + rt * 64 + sr) * 512 + h * 128 + sc;
              *reinterpret_cast<bf16x8*>(Kt + rt * 16384 + KSWZ(sr, sc * 2)) = *reinterpret_cast<const bf16x8*>(s0);
              *reinterpret_cast<bf16x8*>(Kt + rt * 16384 + KSWZ(32 + sr, sc * 2)) = *reinterpret_cast<const bf16x8*>(s0 + 32 * 512); } }
        stage_img<2, false>(p.P() + (size_t)r0 * NPROJ + C_MV + h * 256, NPROJ, Vimg, nullptr, tid);
        if (tid < 256) { const int dir = tid >> 7, s = tid & 127; tabA[tid] = p.GA()[(size_t)((b * 4 + h) * 2 + dir) * LP + c * 128 + s]; }
        bf16x8 qr[8];
        { const bf16_t* Qw = p.Qc() + (size_t)(r0 + t) * 512 + h * 128 + hi * 8;
#pragma unroll
          for (int d0 = 0; d0 < 8; ++d0) qr[d0] = *reinterpret_cast<const bf16x8*>(Qw + d0 * 16); }
        __syncthreads();
        f32x16 s0a, s0b, s1a, s1b;
        att::qkt(s0a, s0b, (const bf16_t*)Kt, qr, r32, hi); att::qkt(s1a, s1b, (const bf16_t*)(Kt + 16384), qr, r32, hi);
        __syncthreads();
        const unsigned pfo = *(const __attribute__((address_space(1))) unsigned char*)((const __attribute__((address_space(1))) char*)p.P()
            + ((size_t)(tok2prow(b * SEQ + (c - 1) * 128 + tt * 32) + (lane >> 1)) * NPROJ + C_MO + h * 256 + dvh * 128) * 2 + (lane & 1) * 128);
#pragma unroll 1
        for (int dir = 0; dir < 2; ++dir) {
            const int seq = (b * 4 + h) * 2 + dir; const size_t sc = (size_t)seq * NCH + c;
            stage_img<2, false>(p.Cst() + sc * 32768, 256, Cimg, nullptr, tid);
            if (tid < 128) tabN[tid] = p.Nst()[sc * 128 + tid];
            const float mc = p.Mst()[sc], pmt = p.GPM()[(size_t)seq * LP + c * 128 + t], bt = p.GB()[(size_t)seq * LP + c * 128 + t];
            const float Mt = fmaxf(mc, pmt), winter = __expf(mc - Mt), einv = __expf(-(bt + Mt));
            __syncthreads();
            int t_o = t, hi_o = hi; asm volatile("" : "+v"(t_o), "+v"(hi_o));
            const float* ta = tabA + dir * 128 + 4 * hi_o; const int tq = t_o - 4 * hi_o;
            float qn = 0.f;
#pragma unroll
            for (int d0 = 0; d0 < 8; ++d0) { const u32x4 u = *reinterpret_cast<const u32x4*>(&qr[d0]); const float* nn = tabN + d0 * 16 + hi * 8;
                qn += bflo(u.x) * nn[0] + bfhi(u.x) * nn[1] + bflo(u.y) * nn[2] + bfhi(u.y) * nn[3] + bflo(u.z) * nn[4] + bfhi(u.z) * nn[5] + bflo(u.w) * nn[6] + bfhi(u.w) * nn[7]; }
            { auto rr = __builtin_amdgcn_permlane32_swap(__float_as_uint(qn), __float_as_uint(qn), false, false); qn = __uint_as_float(rr[0]) + __uint_as_float(rr[1]); }
            if (hi == 0) ws[r32] = winter;
            f32x16 o[4] = {};
            const int vbC = (int)(uintptr_t)Cimg + v_rd_base(lane) + dvh * 32768, vbV = (int)(uintptr_t)Vimg + v_rd_base(lane) + dvh * 32768;
            pv_d0(o, vbC, qr[0], qr[1], qr[2], qr[3]); pv_d0(o, vbC + 16384, qr[4], qr[5], qr[6], qr[7]);
            asm volatile("s_waitcnt lgkmcnt(0)" ::: "memory");
#pragma unroll
            for (int r = 0; r < 16; ++r) { const float wi = ws[crow(r, hi)];
#pragma unroll
                for (int d0 = 0; d0 < 4; ++d0) o[d0][r] *= wi; }
            __builtin_amdgcn_sched_barrier(0);
            float rs = 0.f; bf16x8 sa0, sa1, sa2, sa3;
#define WGT(SV, KB, OUT0, OUT1) do { float e[16]; _Pragma("unroll") for (int r = 0; r < 16; ++r) { const int s4 = (KB) + (r & 3) + 8 * (r >> 2); const int d = dir ? s4 - tq : tq - s4; \
                const float w = __expf(ta[s4] - Mt + (float)min(d, 0) * 1e30f); e[r] = SV[r] * w; rs += e[r]; } \
                { unsigned a0 = cvt_pk_bf16(e[0], e[1]), a1 = cvt_pk_bf16(e[2], e[3]), b0 = cvt_pk_bf16(e[4], e[5]), b1 = cvt_pk_bf16(e[6], e[7]); \
                  auto x0 = __builtin_amdgcn_permlane32_swap(a0, b0, false, false); auto x1 = __builtin_amdgcn_permlane32_swap(a1, b1, false, false); u32x4 w4 = {x0[0], x1[0], x0[1], x1[1]}; OUT0 = *reinterpret_cast<bf16x8*>(&w4); } \
                { unsigned a0 = cvt_pk_bf16(e[8], e[9]), a1 = cvt_pk_bf16(e[10], e[11]), b0 = cvt_pk_bf16(e[12], e[13]), b1 = cvt_pk_bf16(e[14], e[15]); \
                  auto x0 = __builtin_amdgcn_permlane32_swap(a0, b0, false, false); auto x1 = __builtin_amdgcn_permlane32_swap(a1, b1, false, false); u32x4 w4 = {x0[0], x1[0], x0[1], x1[1]}; OUT1 = *reinterpret_cast<bf16x8*>(&w4); } } while (0)
            WGT(s0a, 0, sa0, sa1); __builtin_amdgcn_sched_barrier(0); WGT(s0b, 32, sa2, sa3); __builtin_amdgcn_sched_barrier(0);
            pv_d0(o, vbV, sa0, sa1, sa2, sa3); __builtin_amdgcn_sched_barrier(0);
            WGT(s1a, 64, sa0, sa1); __builtin_amdgcn_sched_barrier(0); WGT(s1b, 96, sa2, sa3); __builtin_amdgcn_sched_barrier(0);
            pv_d0(o, vbV + 16384, sa0, sa1, sa2, sa3);
#undef WGT
            { auto rr = __builtin_amdgcn_permlane32_swap(__float_as_uint(rs), __float_as_uint(rs), false, false); rs = __uint_as_float(rr[0]) + __uint_as_float(rr[1]); }
            const float den = winter * qn + rs; const float hscale = __builtin_amdgcn_rcpf(fmaxf(fabsf(den), einv));
            if (hi == 0) ws[32 + r32] = hscale;
            asm volatile("s_waitcnt lgkmcnt(0)" ::: "memory");
            int r32o = r32, hi_e = hi; asm volatile("" : "+v"(r32o), "+v"(hi_e));
            const unsigned tok0 = (unsigned)(b * SEQ + (c - 1) * 128 + tt * 32), colo = (unsigned)(h * 256 + dvh * 128 + r32o);
            if (dir == 0) {
#pragma unroll
                for (int r = 0; r < 16; ++r) { const float hs_ = ws[32 + crow(r, hi_e)]; float* hp = (float*)((char*)p.HS() + ((tok0 + crow(r, hi_e)) * 1024u + colo) * 4u);
#pragma unroll
                    for (int d0 = 0; d0 < 4; ++d0) hp[d0 * 32] = o[d0][r] * hs_; }
            } else {
                asm volatile("" :: "v"(pfo));
                const unsigned prow0 = (unsigned)tok2prow((int)tok0);
#pragma unroll
                for (int r2 = 0; r2 < 16; r2 += 4) { float hq[4][4]; bf16_t oq[4][4];
#pragma unroll
                    for (int q = 0; q < 4; ++q) { const unsigned tok = tok0 + crow(r2 + q, hi_e);
                        const float* hp = (const float*)((const char*)p.HS() + (tok * 1024u + colo) * 4u); const bf16_t* op = (const bf16_t*)((const char*)p.P() + ((prow0 + crow(r2 + q, hi_e)) * (unsigned)NPROJ + C_MO + colo) * 2u);
#pragma unroll
                        for (int d0 = 0; d0 < 4; ++d0) { hq[q][d0] = hp[d0 * 32]; oq[q][d0] = op[d0 * 32]; } }
                    __builtin_amdgcn_sched_barrier(0);
#pragma unroll
                    for (int q = 0; q < 4; ++q) { const int r = r2 + q; const float hs_ = ws[32 + crow(r, hi_e)]; const unsigned tok = tok0 + crow(r, hi_e);
                        bf16_t* yp = (bf16_t*)((char*)p.YDM() + (((unsigned)NTOK + tok) * 1024u + colo) * 2u);
#pragma unroll
                        for (int d0 = 0; d0 < 4; ++d0) { const float hv = hq[q][d0] + o[d0][r] * hs_; const float g = __builtin_amdgcn_rcpf(1.0f + __expf(-bf2f(oq[q][d0])));
                            yp[d0 * 32] = (bf16_t)(cvt_pk_bf16(g * hv, 0.f) & 0xffffu); } }
                    asm volatile("" ::: "memory"); }
            }
            __syncthreads();
        }
    }
}
#undef KSWZ
}

struct SchedBranch { static constexpr bool BTILED = false; static constexpr bool GATHER = false; pg8::TileOrder T;
    __device__ bool next(int i, pg8::Unit& u) const { int pm, pn; if (!T.tile(i >> 1, pm, pn)) return false; const int which = 1 - (i & 1);
        u.a0 = which * NTOK + pm * 256; u.b0 = which * 2048 + pn * 256; u.r0 = pm * 256; u.c0 = pn * 256; u.aux = which; u.nv = 256; u.rot = 0; return true; }
    __device__ int arow(const pg8::Unit&, int) const { return 0; } };
struct EpiBranch { static constexpr bool PERM = true; bf16_t* MIX; const bf16_t* P;
    __device__ __forceinline__ pg8::PF prefetch(const pg8::Unit& u, int tid) const { unsigned v[4];
#pragma unroll
        for (int j = 0; j < 4; ++j) { const int L = j * 512 + tid, row = L >> 3, seg = L & 7; v[j] = *(const __attribute__((address_space(1))) unsigned char*)((const __attribute__((address_space(1))) char*)P + ((size_t)tok2prow(u.r0 + row) * NPROJ + 6144 + u.c0 + (seg >> 2) * 2048) * 2 + (seg & 3) * 128); }
        return pg8::PF{v[0], v[1], v[2], v[3]}; }
    __device__ __forceinline__ bool keep(const pg8::Unit& u) const { return u.aux == 1; }
    __device__ __forceinline__ void operator()(f32x4 (&acc)[2][2][4][2], const pg8::Unit& u, int wr, int wc, int fr, int fq) const {
        const int col0 = u.c0 + wc * 32 + 8 * fq; const int which = u.aux;
#pragma unroll
        for (int ai = 0; ai < 2; ++ai)
#pragma unroll
            for (int m2 = 0; m2 < 4; m2 += 2) { u32x4 g0r[2][2], g1r[2][2];
#pragma unroll
                for (int q = 0; q < 2; ++q) { const int tok = u.r0 + ai * 128 + wr * 64 + (m2 + q) * 16 + fr; const bf16_t* gp = P + (size_t)tok2prow(tok) * NPROJ + 6144 + col0;
#pragma unroll
                    for (int bj = 0; bj < 2; ++bj) { g0r[q][bj] = *(const u32x4*)(gp + bj * 128); if (which == 1) g1r[q][bj] = *(const u32x4*)(gp + 2048 + bj * 128); } }
#pragma unroll
                for (int q = 0; q < 2; ++q) { const int m = m2 + q; const int tok = u.r0 + ai * 128 + wr * 64 + m * 16 + fr;
#pragma unroll
                    for (int bj = 0; bj < 2; ++bj) { const u32x4 g0 = g0r[q][bj];
                        f32x4 v0 = acc[ai][bj][m][0], v1 = acc[ai][bj][m][1];
                        if (which == 1) { const u32x4 g1 = g1r[q][bj];
                            v0[0] *= bflo(g1.x) * __builtin_amdgcn_rcpf(bflo(g0.x)); v0[1] *= bfhi(g1.x) * __builtin_amdgcn_rcpf(bfhi(g0.x)); v0[2] *= bflo(g1.y) * __builtin_amdgcn_rcpf(bflo(g0.y)); v0[3] *= bfhi(g1.y) * __builtin_amdgcn_rcpf(bfhi(g0.y));
                            v1[0] *= bflo(g1.z) * __builtin_amdgcn_rcpf(bflo(g0.z)); v1[1] *= bfhi(g1.z) * __builtin_amdgcn_rcpf(bfhi(g0.z)); v1[2] *= bflo(g1.w) * __builtin_amdgcn_rcpf(bflo(g0.w)); v1[3] *= bfhi(g1.w) * __builtin_amdgcn_rcpf(bfhi(g0.w));
                            acc[ai][bj][m][0] = v0; acc[ai][bj][m][1] = v1;
                        } else {
                            v0[0] *= bflo(g0.x); v0[1] *= bfhi(g0.x); v0[2] *= bflo(g0.y); v0[3] *= bfhi(g0.y); v1[0] *= bflo(g0.z); v1[1] *= bfhi(g0.z); v1[2] *= bflo(g0.w); v1[3] *= bfhi(g0.w);
#pragma unroll
                            for (int j = 0; j < 4; ++j) { v0[j] = __builtin_amdgcn_fmed3f(v0[j], -448.f, 448.f); v1[j] = __builtin_amdgcn_fmed3f(v1[j], -448.f, 448.f); }
                            u32x2 w; w.x = pk4_fp8(v0[0], v0[1], v0[2], v0[3]); w.y = pk4_fp8(v1[0], v1[1], v1[2], v1[3]);
                            *(u32x2*)((unsigned char*)MIX + (size_t)tok * D + col0 + bj * 128) = w; } } } }
    }
};
struct SchedOut { static constexpr bool BTILED = true; static constexpr bool GATHER = false; pg8::TileOrder T;
    __device__ bool next(int i, pg8::Unit& u) const { int pm, pn; if (!T.tile(i, pm, pn)) return false; u.a0 = pm * 256; u.b0 = pn * 256; u.r0 = pm * 256; u.c0 = pn * 256; u.aux = 0; u.nv = 256; u.rot = 0; return true; }
    __device__ int arow(const pg8::Unit&, int) const { return 0; } };
struct EpiOut { __device__ __forceinline__ bool keep(const pg8::Unit&) const { return false; } static constexpr bool PERM = true; const float* x; bf16_t* H1;
    __device__ __forceinline__ pg8::PF prefetch(const pg8::Unit& u, int tid) const { unsigned v[4];
#pragma unroll
        for (int j = 0; j < 4; ++j) { const int L = j * 512 + tid, row = L >> 3, seg = L & 7; v[j] = *(const __attribute__((address_space(1))) unsigned char*)((const __attribute__((address_space(1))) char*)x + ((size_t)(u.r0 + row) * D + u.c0) * 4 + seg * 128); }
        return pg8::PF{v[0], v[1], v[2], v[3]}; }
    __device__ __forceinline__ void operator()(f32x4 (&acc)[2][2][4][2], const pg8::Unit& u, int wr, int wc, int fr, int fq) const {
        const int row0 = u.r0 + wr * 64 + fr, col0 = u.c0 + wc * 32 + 8 * fq;
#pragma unroll
        for (int ai = 0; ai < 2; ++ai)
#pragma unroll
            for (int m2 = 0; m2 < 4; m2 += 2) { f32x4 xr[2][2][2];
#pragma unroll
                for (int q = 0; q < 2; ++q) { const size_t o = (size_t)(row0 + ai * 128 + (m2 + q) * 16) * D + col0;
#pragma unroll
                    for (int bj = 0; bj < 2; ++bj) { xr[q][bj][0] = *(const f32x4*)(x + o + bj * 128); xr[q][bj][1] = *(const f32x4*)(x + o + bj * 128 + 4); } }
#pragma unroll
                for (int q = 0; q < 2; ++q) { const int m = m2 + q; const size_t o = (size_t)(row0 + ai * 128 + m * 16) * D + col0;
#pragma unroll
                    for (int bj = 0; bj < 2; ++bj) { const f32x4 v0 = xr[q][bj][0] + acc[ai][bj][m][0] * (1.0f / W8_SCALE), v1 = xr[q][bj][1] + acc[ai][bj][m][1] * (1.0f / W8_SCALE);
                        u32x4 w; w.x = cvt_pk_bf16(v0[0], v0[1]); w.y = cvt_pk_bf16(v0[2], v0[3]); w.z = cvt_pk_bf16(v1[0], v1[1]); w.w = cvt_pk_bf16(v1[2], v1[3]);
                        *(u32x4*)(H1 + o + bj * 128) = w; } } }
    }
};

__device__ __forceinline__ void phase_router(const Params& p, unsigned char* lds_) {
    typedef float f32x16 __attribute__((ext_vector_type(16)));
    LAS unsigned char* lds = (LAS unsigned char*)lds_;
    LAS float* LPart = (LAS float*)lds;
    LAS float* SsqP = (LAS float*)(lds + 32768);
    LAS float* Lg = (LAS float*)(lds + 32768 + 2048);
    LAS float* rsv = (LAS float*)(lds + 32768 + 2048 + 4352);
    LAS int* selE = (LAS int*)(lds + 40960);
    LAS int* baseE = selE + 128;
    const int tid = otid(), wid = tid >> 6, lane = tid & 63, i = lane & 31, hi = lane >> 5;
    for (int tb = blockIdx.x; tb < NTOK / 32; tb += gridDim.x) {
        const int tok0 = tb * 32;
        {
            const bf16_t* hrow = p.H1() + (size_t)(tok0 + i) * D + wid * 256 + hi * 128;
            const float* gptr = p.norm_ffn + wid * 256 + hi * 128;
            const float* wr = p.w_router + (size_t)(wid * 256 + hi * 128) * NE + i;
            f32x16 acc = {}; float ssq = 0.f;
#pragma unroll 8
            for (int s4 = 0; s4 < 32; ++s4) { const u32x2 hu = *(const u32x2*)(hrow + s4 * 4); const float4 a = make_float4(bflo(hu.x), bfhi(hu.x), bflo(hu.y), bfhi(hu.y)); const float4 g = *(const float4*)(gptr + s4 * 4);
                ssq += a.x * a.x + a.y * a.y + a.z * a.z + a.w * a.w;
                const float b0 = wr[(s4 * 4 + 0) * NE], b1 = wr[(s4 * 4 + 1) * NE], b2 = wr[(s4 * 4 + 2) * NE], b3 = wr[(s4 * 4 + 3) * NE];
                acc = __builtin_amdgcn_mfma_f32_32x32x2f32(a.x * g.x, b0, acc, 0, 0, 0); acc = __builtin_amdgcn_mfma_f32_32x32x2f32(a.y * g.y, b1, acc, 0, 0, 0);
                acc = __builtin_amdgcn_mfma_f32_32x32x2f32(a.z * g.z, b2, acc, 0, 0, 0); acc = __builtin_amdgcn_mfma_f32_32x32x2f32(a.w * g.w, b3, acc, 0, 0, 0); }
#pragma unroll
            for (int r = 0; r < 16; ++r) { const int row = (r & 3) + 8 * (r >> 2) + 4 * hi; LPart[(wid * 32 + row) * 32 + i] = acc[r]; }
            SsqP[(wid * 2 + hi) * 32 + i] = ssq;
        }
        __syncthreads();
#pragma unroll
        for (int q = 0; q < 2; ++q) { const int idx = tid + 512 * q, tok = idx >> 5, e = idx & 31; float s = 0.f, ss = 0.f;
#pragma unroll
            for (int w = 0; w < 8; ++w) s += LPart[(w * 32 + tok) * 32 + e];
#pragma unroll
            for (int j = 0; j < 16; ++j) ss += SsqP[j * 32 + tok];
            const float rs = rsqrtf(ss / D + EPS); Lg[tok * 33 + e] = rs * s + p.b_router[e]; if (e == 0) rsv[tok] = rs; }
        __syncthreads();
#pragma unroll
        for (int q = 0; q < 4; ++q) { const int tok = wid * 4 + q; float cur = Lg[tok * 33 + i]; float tv[4]; int ti[4];
#pragma unroll
            for (int r = 0; r < 4; ++r) { float bv = cur; int bi = i;
#pragma unroll
                for (int o = 16; o >= 1; o >>= 1) { const float ov = __shfl_xor(bv, o); const int oi = __shfl_xor(bi, o); if (ov > bv || (ov == bv && oi < bi)) { bv = ov; bi = oi; } }
                tv[r] = bv; ti[r] = bi; if (i == bi) cur = -3e38f; }
            float ex[4], sm = 0.f;
#pragma unroll
            for (int r = 0; r < 4; ++r) { ex[r] = __expf(tv[r] - tv[0]); sm += ex[r]; }
            if (lane == 0) {
#pragma unroll
                for (int r = 0; r < 4; ++r) { selE[tok * 4 + r] = ti[r]; p.topW()[(size_t)(tok0 + tok) * 4 + r] = ex[r] / sm; } } }
        __syncthreads();
        if (tid < 32) { int c = 0; for (int j = 0; j < 128; ++j) c += (selE[j] == tid) ? 1 : 0; baseE[tid] = c ? atomicAdd(&p.cursor()[tid], c) : 0; }
        __syncthreads();
        if (tid < 128) { const int e = selE[tid]; int rank = 0; for (int j = 0; j < tid; ++j) rank += (selE[j] == e) ? 1 : 0; const int pos = baseE[e] + rank;
            p.list()[e * ECAP + pos] = tok0 + (tid >> 2); p.dest()[(size_t)(tok0 + (tid >> 2)) * 4 + (tid & 3)] = e * ECAP + pos; }
        { u32x2 hu[4][8]; float4 g[8];
#pragma unroll
          for (int c8 = 0; c8 < 8; ++c8) g[c8] = *(const float4*)(p.norm_ffn + c8 * 256 + lane * 4);
#pragma unroll
          for (int q = 0; q < 4; ++q)
#pragma unroll
            for (int c8 = 0; c8 < 8; ++c8) hu[q][c8] = *(const u32x2*)(p.H1() + (size_t)(tok0 + wid * 4 + q) * D + c8 * 256 + lane * 4);
#pragma unroll
          for (int q = 0; q < 4; ++q) { const int tok = wid * 4 + q; const float rs = rsv[tok];
#pragma unroll
            for (int c8 = 0; c8 < 8; ++c8) { const int col = c8 * 256 + lane * 4; const float4 a = make_float4(bflo(hu[q][c8].x), bfhi(hu[q][c8].x), bflo(hu[q][c8].y), bfhi(hu[q][c8].y));
                *(unsigned*)((unsigned char*)p.HN() + (size_t)(tok0 + tok) * D + col) = pk4_fp8(a.x * rs * g[c8].x, a.y * rs * g[c8].y, a.z * rs * g[c8].z, a.w * rs * g[c8].w); } } }
        __syncthreads();
    }
}
constexpr int MT_OFF = 131072, MT_BIAS = 3584;
constexpr float Y8_SCALE = 16.0f;
__device__ __forceinline__ int rfl(int v) { return __builtin_amdgcn_readfirstlane(v); }
template <int NPN>
__device__ __forceinline__ void moe_tables(const Params& p, unsigned char* lds_) {
    LAS int* tab = (LAS int*)((LAS unsigned char*)lds_ + MT_OFF);
    const int tid = otid(), lane = tid & 63;
    if (tid < 32) { const int e = lane, c = p.cursor()[e], ntl = (c + 255) >> 8; int incl = ntl;
#pragma unroll
        for (int o = 1; o < 32; o <<= 1) { const int t = __shfl_up(incl, o); if (lane >= o) incl += t; }
        const int toff = incl - ntl; tab[e] = c; tab[32 + e] = toff * 256;
        for (int j = 0; j < ntl; ++j) { tab[96 + toff + j] = e; tab[256 + toff + j] = j; }
        if (e == 31) tab[64] = incl; }
    __syncthreads();
    { const int T = tab[64], c = blockIdx.x, xs = c & 7, sx = c >> 3, ngrp = (T + 3) >> 2, nblk = NPN == 16 ? ngrp * 2 : ngrp; bool valid = false;
      if (tid < 16) { const int b = tid * 8 + xs; if (b < nblk) { const int g = NPN == 16 ? (b >> 1) : b, half = NPN == 16 ? (b & 1) : 0, tile = 4 * g + (sx & 3), pn = half * 8 + (sx >> 2);
          if (tile < T) { valid = true; const int e = tab[96 + tile], j = tab[256 + tile], cnt = tab[e], cb = tab[32 + e]; LAS int* u = tab + 448 + tid * 8; const int rem = cnt - j * 256;
              if (NPN == 16) { u[0] = tid * 256; u[1] = e * 4096 + pn * 256; u[2] = cb + j * 256; u[3] = pn * 128; u[4] = e; u[5] = rem < 256 ? rem : 256; u[6] = 0; u[7] = e * ECAP + j * 256; }
              else { u[0] = cb + j * 256; u[1] = e * 2048 + pn * 256; u[2] = cb + j * 256; u[3] = pn * 256; u[4] = e; u[5] = 256; u[6] = 0; u[7] = 0; } } } }
      if (tid < 64) { const unsigned long long m = __ballot(valid); if (tid == 0) tab[65] = __popcll(m); } }
    __syncthreads();
    if (NPN == 16) { const int nun = tab[65];
        for (int idx = tid; idx < nun * 256; idx += 512) { const int i = idx >> 8, row = idx & 255, nv = tab[448 + i * 8 + 5], src = tab[448 + i * 8 + 7]; tab[1024 + idx] = p.list()[src + (row < nv ? row : 0)]; } }
    { const int nun = tab[65]; LAS float* bl = (LAS float*)(tab + MT_BIAS);
        for (int idx = tid; idx < nun * 256; idx += 512) { const int i = idx >> 8, c = idx & 255, e = tab[448 + i * 8 + 4], c0 = tab[448 + i * 8 + 3];
            bl[idx] = NPN == 16 ? p.b1[(size_t)e * 4096 + (c < 128 ? c0 + c : 2048 + c0 + c - 128)] : p.b2[(size_t)e * D + c0 + c]; } }
    __syncthreads();
}
struct SchedMoe1 { static constexpr bool BTILED = true; static constexpr bool GATHER = true; const LAS int* tab;
    __device__ bool next(int i, pg8::Unit& u) const { if (i >= rfl(tab[65])) return false; const LAS int* q = tab + 448 + i * 8;
        u.a0 = rfl(q[0]); u.b0 = rfl(q[1]); u.r0 = rfl(q[2]); u.c0 = rfl(q[3]); u.aux = rfl(q[4]); u.nv = rfl(q[5]); u.rot = rfl(q[6]); u.bo = i * 256; return true; }
    __device__ int arow(const pg8::Unit& u, int row) const { return tab[1024 + u.a0 + row]; } };
struct SchedMoe2 { static constexpr bool BTILED = true; static constexpr bool GATHER = false; const LAS int* tab;
    __device__ bool next(int i, pg8::Unit& u) const { if (i >= rfl(tab[65])) return false; const LAS int* q = tab + 448 + i * 8;
        u.a0 = rfl(q[0]); u.b0 = rfl(q[1]); u.r0 = rfl(q[2]); u.c0 = rfl(q[3]); u.aux = rfl(q[4]); u.nv = rfl(q[5]); u.rot = rfl(q[6]); u.bo = i * 256; return true; }
    __device__ int arow(const pg8::Unit&, int) const { return 0; } };
struct EpiSwiglu { __device__ __forceinline__ pg8::PF prefetch(const pg8::Unit&, int) const { return pg8::PF{0u, 0u, 0u, 0u}; } __device__ __forceinline__ bool keep(const pg8::Unit&) const { return false; } static constexpr bool PERM = true; bf16_t* ACT; const LAS float* bl;
    __device__ __forceinline__ void operator()(f32x4 (&acc)[2][2][4][2], const pg8::Unit& u, int wr, int wc, int fr, int fq) const {
        const int row0 = u.r0 + wr * 64 + fr, col0 = u.c0 + wc * 32 + 8 * fq; const LAS float* bg = bl + u.bo + wc * 32 + 8 * fq;
        f32x4 bgv[2], blv[2];
#pragma unroll
        for (int n = 0; n < 2; ++n) { bgv[n] = *(const LAS f32x4*)(bg + 4 * n); blv[n] = *(const LAS f32x4*)(bg + 128 + 4 * n); }
#pragma unroll
        for (int ai = 0; ai < 2; ++ai)
#pragma unroll
            for (int m = 0; m < 4; ++m) { f32x4 o[2];
#pragma unroll
                for (int n = 0; n < 2; ++n) { const f32x4 g4 = acc[ai][0][m][n] * (1.0f / W8_SCALE) + bgv[n], l4 = acc[ai][1][m][n] * (1.0f / W8_SCALE) + blv[n];
#pragma unroll
                    for (int j = 0; j < 4; ++j) { const float g = fminf(g4[j], 7.0f), l = fminf(fmaxf(l4[j], -7.0f), 7.0f); o[n][j] = g * __builtin_amdgcn_rcpf(1.0f + __expf(-1.702f * g)) * (l + 1.0f); } }
                u32x2 w; w.x = pk4_fp8(o[0][0], o[0][1], o[0][2], o[0][3]); w.y = pk4_fp8(o[1][0], o[1][1], o[1][2], o[1][3]);
                *(u32x2*)((unsigned char*)ACT + (size_t)(row0 + ai * 128 + m * 16) * DFF + col0) = w; }
    }
};
struct EpiY { __device__ __forceinline__ pg8::PF prefetch(const pg8::Unit&, int) const { return pg8::PF{0u, 0u, 0u, 0u}; } __device__ __forceinline__ bool keep(const pg8::Unit&) const { return false; } static constexpr bool PERM = true; bf16_t* Y; const LAS float* bl;
    __device__ __forceinline__ void operator()(f32x4 (&acc)[2][2][4][2], const pg8::Unit& u, int wr, int wc, int fr, int fq) const {
        const int row0 = u.r0 + wr * 64 + fr, col0 = u.c0 + wc * 32 + 8 * fq; const LAS float* bb = bl + u.bo + wc * 32 + 8 * fq;
        f32x4 bv[2][2];
#pragma unroll
        for (int bj = 0; bj < 2; ++bj)
#pragma unroll
            for (int n = 0; n < 2; ++n) bv[bj][n] = *(const LAS f32x4*)(bb + bj * 128 + 4 * n);
#pragma unroll
        for (int ai = 0; ai < 2; ++ai)
#pragma unroll
            for (int m = 0; m < 4; ++m) { unsigned char* rowp = (unsigned char*)Y + (size_t)(row0 + ai * 128 + m * 16) * D + col0;
#pragma unroll
                for (int bj = 0; bj < 2; ++bj) { f32x4 v0 = (acc[ai][bj][m][0] * (1.0f / W8_SCALE) + bv[bj][0]) * Y8_SCALE, v1 = (acc[ai][bj][m][1] * (1.0f / W8_SCALE) + bv[bj][1]) * Y8_SCALE;
#pragma unroll
                    for (int j = 0; j < 4; ++j) { v0[j] = __builtin_amdgcn_fmed3f(v0[j], -448.f, 448.f); v1[j] = __builtin_amdgcn_fmed3f(v1[j], -448.f, 448.f); }
                    u32x2 w; w.x = pk4_fp8(v0[0], v0[1], v0[2], v0[3]); w.y = pk4_fp8(v1[0], v1[1], v1[2], v1[3]);
                    *(u32x2*)(rowp + bj * 128) = w; } }
    }
};
__device__ __forceinline__ void phase_final(const Params& p) {
    const int tid = otid(), wid = tid >> 6, lane = tid & 63;
    int cb = 0; { const int c = lane < NE ? p.cursor()[lane] : 0; int pad = ((c + 255) >> 8) << 8; int incl = pad;
#pragma unroll
        for (int o = 1; o < 32; o <<= 1) { const int t = __shfl_up(incl, o); if ((lane & 31) >= o) incl += t; }
        cb = incl - pad; }
    static_assert(NTOK == NWG * 8 * 4, "final: four tokens per wave");
    int4 dA[4]; float4 wA[4];
#pragma unroll
    for (int q = 0; q < 4; ++q) { const int tk = blockIdx.x * 8 + wid + q * NWG * 8; dA[q] = *(const int4*)(p.dest() + (size_t)tk * 4); wA[q] = *(const float4*)(p.topW() + (size_t)tk * 4); }
    u32x2 hb[8]; unsigned yb[4][8]; float4 g[8];
#pragma unroll
    for (int c8 = 0; c8 < 8; ++c8) g[c8] = *(const float4*)(p.norm_final + c8 * 256 + lane * 4);
#define FIN_LOAD(q_) do { const int tk_ = blockIdx.x * 8 + wid + (q_) * NWG * 8; const int dd_[4] = {dA[q_].x, dA[q_].y, dA[q_].z, dA[q_].w}; \
        _Pragma("unroll") for (int c8 = 0; c8 < 8; ++c8) hb[c8] = *(const u32x2*)(p.H1() + (size_t)tk_ * D + c8 * 256 + lane * 4); \
        _Pragma("unroll") for (int k = 0; k < 4; ++k) { const size_t yr_ = (size_t)(__shfl(cb, dd_[k] >> 13) + (dd_[k] & (ECAP - 1))) * D; \
            _Pragma("unroll") for (int c8 = 0; c8 < 8; ++c8) yb[k][c8] = *(const unsigned*)((const unsigned char*)p.Y() + yr_ + c8 * 256 + lane * 4); } } while (0)
    FIN_LOAD(0);
#pragma unroll
    for (int q = 0; q < 4; ++q) { const int tk = blockIdx.x * 8 + wid + q * NWG * 8;
        const float w[4] = {wA[q].x * (1.0f / Y8_SCALE), wA[q].y * (1.0f / Y8_SCALE), wA[q].z * (1.0f / Y8_SCALE), wA[q].w * (1.0f / Y8_SCALE)};
        float4 v[8]; float ss = 0.f;
#pragma unroll
        for (int c8 = 0; c8 < 8; ++c8) { float4 a = make_float4(bflo(hb[c8].x), bfhi(hb[c8].x), bflo(hb[c8].y), bfhi(hb[c8].y));
#pragma unroll
            for (int k = 0; k < 4; ++k) { unsigned y = yb[k][c8]; asm volatile("" : "+v"(y));
                const auto lo = __builtin_amdgcn_cvt_pk_f32_fp8((int)y, false), hi2 = __builtin_amdgcn_cvt_pk_f32_fp8((int)y, true);
                a.x += w[k] * lo[0]; a.y += w[k] * lo[1]; a.z += w[k] * hi2[0]; a.w += w[k] * hi2[1]; }
            v[c8] = a; ss += a.x * a.x + a.y * a.y + a.z * a.z + a.w * a.w; }
        if (q < 3) FIN_LOAD(q + 1);
        ss = wave_sum(ss); const float rs = rsqrtf(ss / D + EPS);
#pragma unroll
        for (int c8 = 0; c8 < 8; ++c8) { const int col = c8 * 256 + lane * 4;
            *(float4*)(p.out + (size_t)tk * D + col) = make_float4(v[c8].x * rs * g[c8].x, v[c8].y * rs * g[c8].y, v[c8].z * rs * g[c8].z, v[c8].w * rs * g[c8].w); }
    }
#undef FIN_LOAD
}

#define XB_TMO      128
#define XB_XCNT(j)  (256  + 64 * (j))
#define XB_XSUB(j)  (1280 + 64 * (j))
#define XB_XGEN(j)  (2304 + 64 * (j))
#define XB_TOP      3328
#define XB_TOPGEN   3392
#define XCD_BAR_WORDS 3456
#define XB_SPIN_CAP (1u << 18)

__device__ __forceinline__ unsigned xb_ld(unsigned* p)              { return __hip_atomic_load(p, __ATOMIC_RELAXED, __HIP_MEMORY_SCOPE_AGENT); }
__device__ __forceinline__ unsigned xb_add(unsigned* p, unsigned v) { return __hip_atomic_fetch_add(p, v, __ATOMIC_RELAXED, __HIP_MEMORY_SCOPE_AGENT); }
__device__ __forceinline__ unsigned xb_xcc_id() { return (unsigned)__builtin_amdgcn_s_getreg((3 << 11) | 20) & 0xFu; }
#define XB_SPIN(cond, bar) do { unsigned _sp = 0; while (cond) { __builtin_amdgcn_s_sleep(1); \
    if ((++_sp & 255u) == 0u) { if (xb_ld(&(bar)[XB_TMO])) break; if (_sp > XB_SPIN_CAP) { atomicAdd(&(bar)[XB_TMO], 1u); break; } } } } while (0)

struct XcdBarrier {
    unsigned* bar; unsigned x;
    volatile LAS unsigned* st;
};

__device__ __forceinline__ XcdBarrier xcd_barrier_post(unsigned* bar, volatile LAS unsigned* st) {
    XcdBarrier b; b.bar = bar; b.x = xb_xcc_id(); b.st = st;
    if (threadIdx.x == 0) (void)xb_add(&bar[XB_XCNT(b.x)], 1u);
    return b;
}
__device__ __forceinline__ void xcd_barrier_complete(unsigned* bar, unsigned x, unsigned& nloc, unsigned& nx) {
    const unsigned G = gridDim.x * gridDim.y * gridDim.z;
    unsigned sum, cnt, mine, sp = 0u;
    for (;;) {
        sum = 0u; cnt = 0u; mine = 0u;
#pragma unroll
        for (unsigned j = 0; j < 16; ++j) { const unsigned c = xb_ld(&bar[XB_XCNT(j)]); sum += c; cnt += (c > 0u) ? 1u : 0u; mine = (j == x) ? c : mine; }
        if (sum == G) break;
        __builtin_amdgcn_s_sleep(1);
        if ((++sp & 255u) == 0u) { if (xb_ld(&bar[XB_TMO])) break; if (sp > XB_SPIN_CAP) { atomicAdd(&bar[XB_TMO], 1u); break; } }
    }
    nloc = mine > 0u ? mine : 1u; nx = cnt > 0u ? cnt : 1u;
}

__device__ __forceinline__ void xcd_barrier(const XcdBarrier& b) {
    asm volatile("s_waitcnt vmcnt(0)" ::: "memory");
    __syncthreads();
    if (threadIdx.x == 0) {
        unsigned* bar = b.bar;
        __builtin_amdgcn_s_waitcnt(0);
        unsigned nloc = b.st[0], nx = b.st[1];
        if (nloc == 0u) { xcd_barrier_complete(bar, b.x, nloc, nx); b.st[0] = nloc; b.st[1] = nx; }
        const unsigned old = xb_add(&bar[XB_XSUB(b.x)], 1u);
        const unsigned gen = old / nloc;
        if (old + 1u == (gen + 1u) * nloc) {
            __builtin_amdgcn_fence(__ATOMIC_RELEASE, "agent");
            asm volatile("s_waitcnt vmcnt(0)" ::: "memory");
            const unsigned og = xb_add(&bar[XB_TOP], 1u);
            const unsigned tg = og / nx;
            if (og + 1u == (tg + 1u) * nx) xb_add(&bar[XB_TOPGEN], 1u);
            else XB_SPIN(xb_ld(&bar[XB_TOPGEN]) == tg, bar);
            __builtin_amdgcn_fence(__ATOMIC_ACQUIRE, "agent");
            xb_add(&bar[XB_XGEN(b.x)], 1u);
            asm volatile("s_waitcnt vmcnt(0)" ::: "memory");
        } else {
            XB_SPIN(xb_ld(&bar[XB_XGEN(b.x)]) == gen, bar);
            __builtin_amdgcn_fence(__ATOMIC_ACQUIRE, "agent");
            asm volatile("s_waitcnt vmcnt(0)" ::: "memory");
        }
    }
    __syncthreads();
}


__device__ __forceinline__ Params load_params() {
    auto kp = __builtin_amdgcn_kernarg_segment_ptr(); asm volatile("" : "+s"(kp));
    Params p; __builtin_memcpy(&p, (const void*)kp, sizeof(Params)); return p;
}
__global__ void __launch_bounds__(512, 2) mk_fwd(Args a) {
    extern __shared__ __attribute__((aligned(16))) unsigned char lds[];
    const int lo = a.ph_lo, hi = a.ph_hi;
#define IN(k) (lo <= (k) && (k) < hi)
    volatile LAS unsigned* xbw = (volatile LAS unsigned*)((LAS unsigned char*)lds + (LDS_BYTES - 16));
    if (threadIdx.x < 4) xbw[threadIdx.x] = 0u;
    __syncthreads();
    XcdBarrier bar; bar.bar = (unsigned*)a.p.ws; bar.x = 0; bar.st = xbw;
    if (hi - lo > 1) bar = xcd_barrier_post((unsigned*)a.p.ws, xbw);
#define SEAM(k) do { if (IN(k) && IN((k) + 1)) xcd_barrier(bar); } while (0)
    if (IN(0)) { const Params p = load_params(); phase0(p, lds); }
    SEAM(0);
    if (IN(1)) { const Params p = load_params();
        if ((int)blockIdx.x < P1_WORKERS) {
        { SchedProj S; S.T.init(NTOK / 256, 6144 / 256, P1_WORKERS, blockIdx.x, 4);     EpiProj E{p.P(), p.biasP(), 1.0f};
          pg8::gemm_phase<EpiProj, SchedProj>((LAS unsigned char*)lds, p.XN(), p.WinT(), 2048, S, E); }
        { SchedGate8 S; S.T.init(NTOK / 256, 4096 / 256, P1_WORKERS, blockIdx.x, 4); EpiProj E{p.P(), p.biasP(), 1.0f / W8_SCALE};
          pg8::gemm_phase<EpiProj, SchedGate8, 1>((LAS unsigned char*)lds, p.XN8(), p.WG8T(), 2048, S, E); }
        if (blockIdx.x < 128) proj_meta(p, blockIdx.x, (float*)lds); }
        else convert_ring(p, lds, (int)blockIdx.x - P1_WORKERS, NWG - P1_WORKERS); }
    SEAM(1);
    if (IN(2)) { const Params p = load_params(); mls::m0_conv_gates(p); phase_attn(p, lds); }
    SEAM(2);
    if (IN(3)) { const Params p = load_params(); phase_yda(p); mls::m1_summaries(p, lds); }
    SEAM(3);
    if (IN(4)) { const Params p = load_params(); mls::m2_scan(p); }
    SEAM(4);
    if (IN(5)) { const Params p = load_params(); mls::m3_outputs(p, lds); }
    SEAM(5);
    if (IN(6)) { const Params p = load_params(); SchedBranch S; S.T.init(NTOK / 256, D / 256, gridDim.x, blockIdx.x); EpiBranch E{p.MIX(), p.P()};
        pg8::gemm_phase<EpiBranch, SchedBranch>((LAS unsigned char*)lds, p.YDM(), p.WbrT(), 1024, S, E); }
    SEAM(6);
    if (IN(7)) { const Params p = load_params(); SchedOut S; S.T.init(NTOK / 256, D / 256, gridDim.x, blockIdx.x); EpiOut E{p.x, p.H1()};
        pg8::gemm_phase<EpiOut, SchedOut, 1>((LAS unsigned char*)lds, p.MIX(), p.WoutT(), 2048, S, E); }
    SEAM(7);
    if (IN(8)) { const Params p = load_params(); phase_router(p, lds); }
    SEAM(8);
    if (IN(9)) { const Params& p = a.p; moe_tables<16>(p, lds); SchedMoe1 S{(const LAS int*)((LAS unsigned char*)lds + MT_OFF)}; EpiSwiglu E{p.ACT(), (const LAS float*)((LAS unsigned char*)lds + MT_OFF) + MT_BIAS};
        pg8::gemm_phase<EpiSwiglu, SchedMoe1, 1>((LAS unsigned char*)lds, p.HN(), p.W1T(), 2048, S, E); }
    SEAM(9);
    if (IN(10)) { const Params p = load_params(); moe_tables<8>(p, lds); SchedMoe2 S{(const LAS int*)((LAS unsigned char*)lds + MT_OFF)}; EpiY E{p.Y(), (const LAS float*)((LAS unsigned char*)lds + MT_OFF) + MT_BIAS};
        pg8::gemm_phase<EpiY, SchedMoe2, 1>((LAS unsigned char*)lds, p.ACT(), p.W2T(), 2048, S, E); }
    SEAM(10);
    if (IN(11)) { const Params p = load_params(); phase_final(p); }
#undef SEAM
#undef IN
}

static void launch_mk(hipStream_t st, const Params& p, int lo, int hi) {
    Args a{}; a.p = p; a.ph_lo = lo; a.ph_hi = hi;
    hipLaunchKernelGGL(mk_fwd, dim3(NWG), dim3(512), LDS_BYTES, st, a);
}

extern "C" void kernel_launch(void* const* d_in, const int* in_sizes, int n_in, void* d_out, int out_size, void* d_ws, size_t ws_size, hipStream_t stream) {
    static int ready = 0;
    if (!ready) {
        if (hipFuncSetAttribute((const void*)mk_fwd, hipFuncAttributeMaxDynamicSharedMemorySize, LDS_BYTES) != hipSuccess) { fprintf(stderr, "kernel_launch: hipFuncSetAttribute failed\n"); return; }
        ready = 1;
    }
    Params p{};
    p.x = (const float*)d_in[0]; p.meta = (const float*)d_in[1]; p.rel_bias = (const float*)d_in[2];
    p.norm_mix = (const float*)d_in[3]; p.w_in = (const float*)d_in[4]; p.conv_w = (const float*)d_in[5];
    p.gate_bias = (const float*)d_in[6]; p.lamp = (const float*)d_in[7]; p.subln = (const float*)d_in[8];
    p.w_bda = (const float*)d_in[9]; p.w_bm = (const float*)d_in[10]; p.w_gate = (const float*)d_in[11];
    p.b_gate = (const float*)d_in[12]; p.w_out = (const float*)d_in[13]; p.norm_ffn = (const float*)d_in[14];
    p.w_router = (const float*)d_in[15]; p.b_router = (const float*)d_in[16]; p.w1 = (const float*)d_in[17];
    p.b1 = (const float*)d_in[18]; p.w2 = (const float*)d_in[19]; p.b2 = (const float*)d_in[20];
    p.norm_final = (const float*)d_in[21];
    p.out = (float*)d_out;
    size_t off = 0;
    p.ws = (unsigned char*)d_ws; off = WS_END;
    if (off > ws_size) { fprintf(stderr, "kernel_launch: workspace too small: need %zu have %zu\n", off, ws_size); return; }
    if (hipMemsetAsync(p.ctl(), 0, 65536, stream) != hipSuccess) { fprintf(stderr, "kernel_launch: memset failed\n"); return; }
#ifndef PROBE_DUP_MASK
    launch_mk(stream, p, 0, 12);
#else
    for (int ph = 0; ph < 12; ++ph) { launch_mk(stream, p, ph, ph + 1); if (((PROBE_DUP_MASK) >> ph) & 1) launch_mk(stream, p, ph, ph + 1); }
#endif
}
```
